# Optimizing an MI355X kernel written in HIP

```python
import math
import jax, jax.numpy as jnp
from jax import lax
import numpy as np


D_MODEL = 2048
BATCH = 1
SEQ = 8192
DEPTH = 1
DEC_BATCH = 8
DEC_SEQ = 2048
PAST_LEN = 128

D_MIX = D_MODEL
D_RWKV = D_MIX // 2
D_DIFF = D_MIX - D_RWKV
RWKV_HEAD = 64
N_RWKV_HEADS = D_RWKV // RWKV_HEAD
DIFF_VDIM = 128
N_DIFF_HEADS = D_DIFF // DIFF_VDIM
DIFF_QK = DIFF_VDIM // 2
LORA_W = 64
LORA_A = 64
ROPE_DIMS = DIFF_QK // 4
ROPE_THETA = 500000.0
Q_BLOCK = 128
RMS_EPS = 1e-6
GN_EPS = 64e-5
DECAY_SCALE = 0.606531

SHIFT_COLS = 3 * D_RWKV + LORA_W + LORA_A
D_IN = SHIFT_COLS + D_RWKV + 4 * D_DIFF

kernel_name = 'hymba_rwkv7_diffattn_bidir_encoder'


def rms_norm(x, g, eps=RMS_EPS):
    xf = x.astype(jnp.float32)
    y = xf * lax.rsqrt(jnp.mean(xf * xf, axis=-1, keepdims=True) + eps)
    return y * g.astype(jnp.float32)


def centred_shift(z, mu):
    prev = jnp.pad(z[:, :-1], ((0, 0), (1, 0), (0, 0)))
    nxt = jnp.pad(z[:, 1:], ((0, 0), (0, 1), (0, 0)))
    return z + mu * (0.5 * (prev + nxt) - z)


def rope_partial(x):
    T = x.shape[1]
    half = ROPE_DIMS // 2
    inv = ROPE_THETA ** (-jnp.arange(half, dtype=jnp.float32) * 2.0 / ROPE_DIMS)
    ang = jnp.arange(T, dtype=jnp.float32)[:, None] * inv[None, :]
    cos = jnp.cos(ang)[None, :, None, None, :]
    sin = jnp.sin(ang)[None, :, None, None, :]
    x1 = x[..., :half]
    x2 = x[..., half:ROPE_DIMS]
    return jnp.concatenate([x1 * cos - x2 * sin, x2 * cos + x1 * sin, x[..., ROPE_DIMS:]], axis=-1)


def rwkv7_scan(r, w, k, v, kk, b, reverse):
    B, T, H, N = r.shape
    seq = tuple(jnp.moveaxis(t, 1, 0) for t in (r, w, k, v, kk, b))

    def step(S, inp):
        r_t, w_t, k_t, v_t, kk_t, b_t = inp
        sa = jnp.einsum('bhvk,bhk->bhv', S, -kk_t)
        S = S * w_t[:, :, None, :] + sa[..., None] * b_t[:, :, None, :] + v_t[..., None] * k_t[:, :, None, :]
        return S, jnp.einsum('bhvk,bhk->bhv', S, r_t)

    S0 = jnp.zeros((B, H, N, N), jnp.float32)
    _, o = lax.scan(step, S0, seq, reverse=reverse)
    return jnp.moveaxis(o, 0, 1)


def rwkv7_mixer(zs, g, w0, w_up, a0, a_up, k_k, k_a, r_k, gn_gain, gn_bias):
    B, T, _ = zs.shape
    H, N = N_RWKV_HEADS, RWKV_HEAD
    hs = lambda t: t.reshape(B, T, H, N)
    r = zs[..., :D_RWKV]
    k = zs[..., D_RWKV:2 * D_RWKV]
    v = zs[..., 2 * D_RWKV:3 * D_RWKV]
    wd = zs[..., 3 * D_RWKV:3 * D_RWKV + LORA_W]
    ad = zs[..., 3 * D_RWKV + LORA_W:]
    kk = hs(k * k_k)
    kk = kk * lax.rsqrt(jnp.maximum(jnp.sum(kk * kk, axis=-1, keepdims=True), 1e-12))
    o = jnp.zeros((B, T, H, N), jnp.float32)
    for d, rev in enumerate((False, True)):
        w = jnp.exp(-DECAY_SCALE * jax.nn.sigmoid(w0[d] + jnp.tanh(wd) @ w_up[d]))
        a = jax.nn.sigmoid(a0[d] + ad @ a_up[d])
        k_d = k * (1.0 + (a - 1.0) * k_a)
        o = o + rwkv7_scan(hs(r), hs(w), hs(k_d), hs(v), kk, hs(a) * kk, rev)
    mean = jnp.mean(o, axis=-1, keepdims=True)
    var = jnp.mean(jnp.square(o - mean), axis=-1, keepdims=True)
    on = ((o - mean) * lax.rsqrt(var + GN_EPS)).reshape(B, T, D_RWKV) * gn_gain + gn_bias
    bonus = jnp.sum(hs(r) * hs(k) * r_k, axis=-1, keepdims=True) * hs(v)
    return (on + bonus.reshape(B, T, D_RWKV)) * jax.nn.silu(g)


def diff_attn_mixer(q, k, v, g, q_gain, k_gain, lambda_qk, subln_gain, lambda_init):
    B, T, _ = q.shape
    H = N_DIFF_HEADS
    qh = rope_partial(rms_norm(q.reshape(B, T, H, 2, DIFF_QK), q_gain))
    kh = rope_partial(rms_norm(k.reshape(B, T, H, 2, DIFF_QK), k_gain))
    vh = v.reshape(B, T, H, DIFF_VDIM)
    scale = DIFF_QK ** -0.5
    lam = (jnp.exp(jnp.sum(lambda_qk[0] * lambda_qk[1])) - jnp.exp(jnp.sum(lambda_qk[2] * lambda_qk[3]))
           + lambda_init)
    nb = T // Q_BLOCK
    qb = jnp.swapaxes(qh.reshape(B, nb, Q_BLOCK, H, 2, DIFF_QK), 0, 1)

    def block(qi):
        s = jnp.einsum('bqhcd,bkhcd->bhcqk', qi, kh) * scale
        p = jax.nn.softmax(s, axis=-1)
        attn = p[:, :, 0] - lam * p[:, :, 1]
        return jnp.einsum('bhqk,bkhd->bqhd', attn, vh)

    o = jnp.swapaxes(lax.map(block, qb), 0, 1).reshape(B, T, H, DIFF_VDIM)
    o = rms_norm(o, subln_gain) * (1.0 - lambda_init)
    return o.reshape(B, T, D_DIFF) * jax.nn.silu(g)


def encoder_layer(x, lambda_init, norm_gain, w_in, mu_shift, w0, w_up, a0, a_up, k_k, k_a, r_k,
                  gn_gain, gn_bias, q_norm_gain, k_norm_gain, lambda_qk, subln_gain, w_out):
    f32 = jnp.float32
    h = rms_norm(x, norm_gain)
    proj = h @ w_in.astype(f32)
    zs = centred_shift(proj[..., :SHIFT_COLS], mu_shift.astype(f32))
    g_r = proj[..., SHIFT_COLS:SHIFT_COLS + D_RWKV]
    off = SHIFT_COLS + D_RWKV
    q_d = proj[..., off:off + D_DIFF]
    k_d = proj[..., off + D_DIFF:off + 2 * D_DIFF]
    v_d = proj[..., off + 2 * D_DIFF:off + 3 * D_DIFF]
    g_d = proj[..., off + 3 * D_DIFF:off + 4 * D_DIFF]
    y_r = rwkv7_mixer(zs, g_r, w0.astype(f32), w_up.astype(f32), a0.astype(f32), a_up.astype(f32),
                      k_k.astype(f32), k_a.astype(f32), r_k.astype(f32), gn_gain.astype(f32), gn_bias.astype(f32))
    y_d = diff_attn_mixer(q_d, k_d, v_d, g_d, q_norm_gain, k_norm_gain, lambda_qk.astype(f32),
                          subln_gain, lambda_init)
    out = jnp.concatenate([y_r, y_d], axis=-1) @ w_out.astype(f32)
    return (x.astype(f32) + out).astype(x.dtype)


def setup_inputs(seed: int = 0) -> dict:
    key = jax.random.key(seed)
    ks = jax.random.split(key, 20)
    nrm = lambda k, shape, s: s * jax.random.normal(k, shape, jnp.float32)
    return {
        'x_prompt': nrm(ks[0], (BATCH, SEQ, D_MODEL), 1.0),
        'x_sample': nrm(ks[1], (DEC_BATCH, DEC_SEQ, D_MODEL), 1.0),
        'norm_gain': 1.0 + nrm(ks[2], (DEPTH, D_MODEL), 0.02),
        'w_in': nrm(ks[3], (DEPTH, D_MODEL, D_IN), D_MODEL ** -0.5),
        'mu_shift': 0.5 + nrm(ks[4], (DEPTH, SHIFT_COLS), 0.1),
        'w0': nrm(ks[5], (DEPTH, 2, D_RWKV), 1.0),
        'w_up': nrm(ks[6], (DEPTH, 2, LORA_W, D_RWKV), 0.1 * LORA_W ** -0.5),
        'a0': nrm(ks[7], (DEPTH, 2, D_RWKV), 0.5),
        'a_up': nrm(ks[8], (DEPTH, 2, LORA_A, D_RWKV), 0.1 * LORA_A ** -0.5),
        'k_k': 0.85 + nrm(ks[9], (DEPTH, D_RWKV), 0.05),
        'k_a': 1.0 + nrm(ks[10], (DEPTH, D_RWKV), 0.05),
        'r_k': nrm(ks[11], (DEPTH, N_RWKV_HEADS, RWKV_HEAD), 0.1),
        'gn_gain': 1.0 + nrm(ks[12], (DEPTH, D_RWKV), 0.02),
        'gn_bias': nrm(ks[13], (DEPTH, D_RWKV), 0.02),
        'q_norm_gain': 1.0 + nrm(ks[14], (DEPTH, DIFF_QK), 0.02),
        'k_norm_gain': 1.0 + nrm(ks[15], (DEPTH, DIFF_QK), 0.02),
        'lambda_qk': nrm(ks[16], (DEPTH, 4, DIFF_QK), 0.1),
        'subln_gain': 1.0 + nrm(ks[17], (DEPTH, DIFF_VDIM), 0.02),
        'w_out': nrm(ks[18], (DEPTH, D_MIX, D_MODEL), D_MIX ** -0.5),
    }


def reference(x_prompt, x_sample, norm_gain, w_in, mu_shift, w0, w_up, a0, a_up, k_k, k_a, r_k,
              gn_gain, gn_bias, q_norm_gain, k_norm_gain, lambda_qk, subln_gain, w_out):
    y_prompt = x_prompt
    y_sample = x_sample
    for l in range(DEPTH):
        lambda_init = 0.8 - 0.6 * math.exp(-0.3 * l)
        params = (norm_gain[l], w_in[l], mu_shift[l], w0[l], w_up[l], a0[l], a_up[l], k_k[l], k_a[l],
                  r_k[l], gn_gain[l], gn_bias[l], q_norm_gain[l], k_norm_gain[l], lambda_qk[l],
                  subln_gain[l], w_out[l])
        y_prompt = encoder_layer(y_prompt, lambda_init, *params)
        y_sample = encoder_layer(y_sample, lambda_init, *params)
    return (y_prompt, y_sample)
```

```cpp
#include <hip/hip_runtime.h>
#include <hip/hip_cooperative_groups.h>
#include <cstdio>
#include <cstdint>
namespace cg = cooperative_groups;
#define MK_N_LAUNCHES 1
namespace pg8 {
#define PG8_LAS __attribute__((address_space(3)))
typedef unsigned short bf16_t;
typedef short bf16x8 __attribute__((ext_vector_type(8)));
typedef float f32x4 __attribute__((ext_vector_type(4)));
typedef unsigned u32x4 __attribute__((ext_vector_type(4)));
constexpr int BM = 256, BK = 64, HALF = 128, HTB = HALF * BK * 2  , STAGE_BYTES = 8 * HTB, NXCD = 8, WGM = 8;

__host__ __device__ __forceinline__ int lds_byte(int r, int c) { const int st = (r >> 4) * 2 + (c >> 5), rr = r & 15, cc = c & 31, ob = rr * 64 + cc * 2; return st * 1024 + (ob ^ (((ob >> 9) & 1) << 5)); }
__host__ __device__ __forceinline__ void stage_rc(int b, int& R, int& C) { const int st = b / 1024, sb = b % 1024, swz = sb ^ (((sb >> 9) & 1) << 5); R = (st >> 1) * 16 + swz / 64; C = (st & 1) * 32 + (swz % 64) / 2; }
__host__ __device__ __forceinline__ int perm32(int rho) { const int n = rho >> 4, i = rho & 15; return 8 * (i >> 2) + 4 * n + (i & 3); }

struct Unit { int pm, pn; };
struct Gemm { const bf16_t* A; const bf16_t* Bt; int M, N, K; };

struct StaticOrder {
    int nM, nN, nwg, G, c;
    __host__ __device__ void init(int M, int N, int G_, int c_) { nM = M / BM; nN = N / BM; nwg = nM * nN; G = G_; c = c_; }
    __host__ __device__ bool next(int i, Unit& u) const {
        const long L = (long)i * G + c; if (L >= nwg) return false;
        int wgid = (int)L; { const int q = nwg / NXCD, r = nwg % NXCD, xcd = wgid % NXCD, off = wgid / NXCD; wgid = (xcd < r ? xcd * (q + 1) : r * (q + 1) + (xcd - r) * q) + off; }
        const int nig = WGM * nN, gid = wgid / nig, fm = gid * WGM, gsz = (nM - fm) < WGM ? (nM - fm) : WGM;
        u.pm = fm + ((wgid % nig) % gsz); u.pn = (wgid % nig) / gsz; return true;
    }
    __device__ __forceinline__ void a_ready(const Unit&) const {}
    __device__ __forceinline__ void done(const Unit&) const {}
};


typedef float f32x2 __attribute__((ext_vector_type(2)));
typedef __bf16 bf16x2_t __attribute__((ext_vector_type(2)));
__device__ __forceinline__ unsigned cvt_pk_bf16(float lo, float hi) { f32x2 v = {lo, hi}; bf16x2_t b = __builtin_convertvector(v, bf16x2_t); return __builtin_bit_cast(unsigned, b); }

struct EpiBf16 {
    static constexpr bool PERM = true, AFTER_DRAIN = false;
    bf16_t* O; int ldc; int nvalid;
    __device__ __forceinline__ void operator()(const f32x4 (&acc)[2][2][4][2], const Unit& u, int wr, int wc, int fr, int fq) const {
        const int row0 = u.pm * BM + wr * 64 + fr; const int col0 = u.pn * BM + wc * 32 + 8 * fq;
#pragma unroll
        for (int ai = 0; ai < 2; ++ai)
#pragma unroll
            for (int m = 0; m < 4; ++m) { bf16_t* rowp = O + (size_t)(row0 + ai * HALF + m * 16) * ldc + col0;
#pragma unroll
                for (int bj = 0; bj < 2; ++bj) { if (col0 + bj * HALF < nvalid) { const f32x4 v0 = acc[ai][bj][m][0], v1 = acc[ai][bj][m][1];
                    u32x4 w; w.x = cvt_pk_bf16(v0[0], v0[1]); w.y = cvt_pk_bf16(v0[2], v0[3]); w.z = cvt_pk_bf16(v1[0], v1[1]); w.w = cvt_pk_bf16(v1[2], v1[3]);
                    *(u32x4*)(rowp + bj * HALF) = w; } } }
    }
};
struct EpiResF32 {
    static constexpr bool PERM = false, AFTER_DRAIN = false;
    const float* xp; const float* xs; float* out;
    __device__ __forceinline__ void operator()(const f32x4 (&acc)[2][2][4][2], const Unit& u, int wr, int wc, int fr, int fq) const {
        const int row0 = u.pm * BM + wr * 64 + fr; const int col0 = u.pn * BM + wc * 32 + 4 * fq;
        const float* xb = (u.pm * BM < 8192) ? xp : (xs - (size_t)8192 * 2048);
#pragma unroll
        for (int ai = 0; ai < 2; ++ai)
#pragma unroll
            for (int m = 0; m < 4; ++m) { const size_t off = (size_t)(row0 + ai * HALF + m * 16) * 2048 + col0;
#pragma unroll
                for (int bj = 0; bj < 2; ++bj)
#pragma unroll
                    for (int n = 0; n < 2; ++n) { const f32x4 xv = *(const f32x4*)(xb + off + bj * HALF + n * 16); *(f32x4*)(out + off + bj * HALF + n * 16) = xv + acc[ai][bj][m][n]; } }
    }
};
template <class Epi, class Sched, bool ALIGN_EPI = false, bool SP2 = false>
__device__ __forceinline__ void gemm_phase(PG8_LAS unsigned char* lds, const Gemm g, const Sched& S, const Epi& E) {
    const int tid = threadIdx.x, wid = __builtin_amdgcn_readfirstlane(tid >> 6), lane = tid & 63, wr = wid >> 2, wc = wid & 3, fr = lane & 15, fq = lane >> 4;
    const int K = g.K, nt = K / BK;
    unsigned voffA[2], voffB[2];
#pragma unroll
    for (int i = 0; i < 2; ++i) { int R, C; stage_rc(tid * 16 + i * 8192, R, C); const int Rb = Epi::PERM ? ((R & ~31) + perm32(R & 31)) : R;
        voffA[i] = (unsigned)(R * K + C) * 2u; voffB[i] = (unsigned)(Rb * K + C) * 2u; }
    const size_t kstep = (size_t)(BK * 2);
    const size_t hstep = (size_t)HALF * K * 2;
    const size_t tstep = 2 * hstep;
    const unsigned ldsw = (unsigned)wid * 1024u;
    const int aoff = lds_byte(wr * 64 + fr, fq * 8), boff = lds_byte(wc * 32 + fr, fq * 8);
#define PG8_SA(b, h) (((b) * 2 + (h)) * HTB)
#define PG8_SB(b, h) ((4 + (b) * 2 + (h)) * HTB)
#define PG8_STAGE(bufoff, gbase, voff) do { _Pragma("unroll") for (int _i = 0; _i < 2; ++_i) \
        __builtin_amdgcn_global_load_lds((const unsigned*)((const char*)(gbase) + (voff)[_i]), (PG8_LAS unsigned*)(lds + (bufoff) + ldsw + _i * 8192), 16, 0, 0); } while (0)
#define PG8_LDA(dst, b, h) do { _Pragma("unroll") for (int m = 0; m < 4; ++m) _Pragma("unroll") for (int k = 0; k < 2; ++k) dst[m][k] = *(const PG8_LAS bf16x8*)(lds + PG8_SA(b, h) + aoff + m * 2048 + k * 1024); } while (0)
#define PG8_LDB(dst, b, h) do { _Pragma("unroll") for (int n = 0; n < 2; ++n) _Pragma("unroll") for (int k = 0; k < 2; ++k) dst[n][k] = *(const PG8_LAS bf16x8*)(lds + PG8_SB(b, h) + boff + n * 2048 + k * 1024); } while (0)
#define PG8_MMA(ai, bj, At, Bt) do { __builtin_amdgcn_s_setprio(1); _Pragma("unroll") for (int m = 0; m < 4; ++m) _Pragma("unroll") for (int n = 0; n < 2; ++n) _Pragma("unroll") for (int k = 0; k < 2; ++k) \
        acc[ai][bj][m][n] = __builtin_amdgcn_mfma_f32_16x16x32_bf16(Bt[n][k], At[m][k], acc[ai][bj][m][n], 0, 0, 0); __builtin_amdgcn_s_setprio(0); } while (0)
#define PG8_WAIT_V(n) asm volatile("s_waitcnt vmcnt(" #n ")" ::: "memory")
#define PG8_WAIT_L(n) asm volatile("s_waitcnt lgkmcnt(" #n ")" ::: "memory")
#define PG8_BAR __builtin_amdgcn_s_barrier()
#define PG8_SCHED __builtin_amdgcn_sched_barrier(0)
    Unit cur, nxt; int ui = 0;
    if (!S.next(0, cur)) return;
    f32x4 acc[2][2][4][2];
#pragma unroll
    for (int a = 0; a < 2; ++a)
#pragma unroll
        for (int b = 0; b < 2; ++b)
#pragma unroll
            for (int m = 0; m < 4; ++m)
#pragma unroll
                for (int n = 0; n < 2; ++n) acc[a][b][m][n] = (f32x4){0.f, 0.f, 0.f, 0.f};
    bf16x8 At[4][2], B0[2][2], B1[2][2];
    const char* cA = (const char*)g.A + (size_t)cur.pm * tstep; const char* cB = (const char*)g.Bt + (size_t)cur.pn * tstep;
    S.a_ready(cur);
    if constexpr (SP2) {
        PG8_STAGE(PG8_SB(0, 0), cB, voffB); PG8_STAGE(PG8_SB(0, 1), cB + hstep, voffB); PG8_STAGE(PG8_SA(0, 0), cA, voffA); PG8_STAGE(PG8_SA(0, 1), cA + hstep, voffA);
        if (wr == 1) PG8_BAR;
        PG8_WAIT_V(2); PG8_BAR;
        PG8_STAGE(PG8_SB(1, 0), cB + kstep, voffB); PG8_STAGE(PG8_SA(1, 0), cA + kstep, voffA); PG8_STAGE(PG8_SB(1, 1), cB + hstep + kstep, voffB);
        PG8_WAIT_V(6); PG8_BAR;
    } else {
        PG8_STAGE(PG8_SB(0, 0), cB, voffB); PG8_STAGE(PG8_SA(0, 0), cA, voffA); PG8_STAGE(PG8_SB(0, 1), cB + hstep, voffB); PG8_STAGE(PG8_SA(0, 1), cA + hstep, voffA);
        if (wr == 1) PG8_BAR;
        PG8_WAIT_V(4); PG8_BAR;
        PG8_STAGE(PG8_SB(1, 0), cB + kstep, voffB); PG8_STAGE(PG8_SA(1, 0), cA + kstep, voffA); PG8_STAGE(PG8_SB(1, 1), cB + hstep + kstep, voffB);
        PG8_WAIT_V(6); PG8_BAR;
    }
    for (;;) {
        const bool has_next = S.next(ui + 1, nxt);
        const char* nA = has_next ? (const char*)g.A + (size_t)nxt.pm * tstep : cA; const char* nB = has_next ? (const char*)g.Bt + (size_t)nxt.pn * tstep : cB;
        for (int t = 0; t < nt; t += 2) {
            const bool last = (t == nt - 2);
            const char* a1 = cA + (size_t)(t + 1) * kstep;
            const char* a2 = last ? nA : cA + (size_t)(t + 2) * kstep; const char* b2 = last ? nB : cB + (size_t)(t + 2) * kstep;
            const char* a3 = a2 + kstep; const char* b3 = b2 + kstep;
            if (last && has_next) S.a_ready(nxt);
            if constexpr (SP2) {
            PG8_LDB(B0, 0, 0); PG8_LDB(B1, 0, 1); PG8_SCHED; PG8_LDA(At, 0, 0); PG8_STAGE(PG8_SA(1, 1), a1 + hstep, voffA);
            PG8_WAIT_V(8); PG8_WAIT_L(0); PG8_BAR; PG8_MMA(0, 0, At, B0); PG8_MMA(0, 1, At, B1); PG8_BAR; PG8_SCHED;
            PG8_LDA(At, 0, 1); PG8_STAGE(PG8_SB(0, 0), b2, voffB); PG8_STAGE(PG8_SB(0, 1), b2 + hstep, voffB); PG8_STAGE(PG8_SA(0, 0), a2, voffA);
            PG8_WAIT_V(8); PG8_WAIT_L(0); PG8_BAR; PG8_MMA(1, 0, At, B0); PG8_MMA(1, 1, At, B1); PG8_BAR; PG8_SCHED;
            PG8_LDB(B0, 1, 0); PG8_LDB(B1, 1, 1); PG8_SCHED; PG8_LDA(At, 1, 0); PG8_STAGE(PG8_SA(0, 1), a2 + hstep, voffA);
            PG8_WAIT_V(8); PG8_WAIT_L(0); PG8_BAR; PG8_MMA(0, 0, At, B0); PG8_MMA(0, 1, At, B1); PG8_BAR; PG8_SCHED;
            PG8_LDA(At, 1, 1); PG8_STAGE(PG8_SB(1, 0), b3, voffB); PG8_STAGE(PG8_SB(1, 1), b3 + hstep, voffB); PG8_STAGE(PG8_SA(1, 0), a3, voffA);
            PG8_WAIT_V(8); PG8_WAIT_L(0); PG8_BAR; PG8_MMA(1, 0, At, B0); PG8_MMA(1, 1, At, B1); PG8_BAR; PG8_SCHED;
            } else {
            PG8_LDB(B0, 0, 0); PG8_SCHED; PG8_LDA(At, 0, 0); PG8_STAGE(PG8_SA(1, 1), a1 + hstep, voffA);
            PG8_WAIT_L(8); PG8_BAR; PG8_WAIT_L(0); PG8_MMA(0, 0, At, B0); PG8_BAR; PG8_SCHED;
            PG8_LDB(B1, 0, 1); PG8_STAGE(PG8_SB(0, 0), b2, voffB);
            PG8_BAR; PG8_WAIT_L(0); PG8_MMA(0, 1, At, B1); PG8_BAR;
            PG8_LDA(At, 0, 1); PG8_STAGE(PG8_SA(0, 0), a2, voffA);
            PG8_BAR; PG8_WAIT_L(0); PG8_MMA(1, 0, At, B0); PG8_BAR; PG8_SCHED;
            PG8_STAGE(PG8_SB(0, 1), b2 + hstep, voffB);
            PG8_WAIT_V(6); PG8_BAR; PG8_MMA(1, 1, At, B1); PG8_BAR;
            PG8_LDB(B0, 1, 0); PG8_SCHED; PG8_LDA(At, 1, 0); PG8_STAGE(PG8_SA(0, 1), a2 + hstep, voffA);
            PG8_WAIT_L(8); PG8_BAR; PG8_WAIT_L(0); PG8_MMA(0, 0, At, B0); PG8_BAR; PG8_SCHED;
            PG8_LDB(B1, 1, 1); PG8_STAGE(PG8_SB(1, 0), b3, voffB);
            PG8_BAR; PG8_WAIT_L(0); PG8_MMA(0, 1, At, B1); PG8_BAR;
            PG8_LDA(At, 1, 1); PG8_STAGE(PG8_SA(1, 0), a3, voffA);
            PG8_BAR; PG8_WAIT_L(0); PG8_MMA(1, 0, At, B0); PG8_BAR; PG8_SCHED;
            PG8_STAGE(PG8_SB(1, 1), b3 + hstep, voffB);
            PG8_WAIT_V(6); PG8_BAR; PG8_MMA(1, 1, At, B1); PG8_BAR;
            }
        }
        if constexpr (ALIGN_EPI) { if (wr == 0) PG8_BAR; }
        if constexpr (!Epi::AFTER_DRAIN) { E(acc, cur, wr, wc, fr, fq); S.done(cur); }
        if (!has_next) break;
#pragma unroll
        for (int a = 0; a < 2; ++a)
#pragma unroll
            for (int b = 0; b < 2; ++b)
#pragma unroll
                for (int m = 0; m < 4; ++m)
#pragma unroll
                    for (int n = 0; n < 2; ++n) acc[a][b][m][n] = (f32x4){0.f, 0.f, 0.f, 0.f};
        cur = nxt; cA = nA; cB = nB; ++ui;
        if constexpr (ALIGN_EPI) { if (wr == 1) PG8_BAR; }
    }
    PG8_WAIT_V(0);
    if constexpr (!ALIGN_EPI) { if (wr == 0) PG8_BAR; }
    PG8_BAR;
    if constexpr (Epi::AFTER_DRAIN) { E.fused(acc, cur, wr, wc, fr, fq, lds, wid, lane); S.done(cur); }
#undef PG8_SA
#undef PG8_SB
#undef PG8_STAGE
#undef PG8_LDA
#undef PG8_LDB
#undef PG8_MMA
#undef PG8_WAIT_V
#undef PG8_WAIT_L
#undef PG8_BAR
#undef PG8_SCHED
}
}

#ifndef MK_N_LAUNCHES
#define MK_N_LAUNCHES 1
#endif
constexpr int NWAVES = 8, NTHREADS = 512;
constexpr int DM = 2048, MTOK = 24576, DIN = 8320, DINP = 8448;
constexpr int C_K = 1024, C_V = 2048, C_WD = 3072, C_AD = 3136, C_GR = 3200, C_QD = 4224, C_KD = 5248, C_VD = 6272, C_GD = 7296;
constexpr size_t MiB = 1u << 20;
constexpr size_t WS_CTL = 0, WS_WOUT = 1 * MiB, WS_PROJ = 10 * MiB, WS_CONCAT = 400 * MiB, WS_WIN = 400 * MiB, WS_END = 496 * MiB, WS_TOTAL = 512 * MiB;
constexpr size_t DO_OF = 48 * MiB, DO_OB = 96 * MiB;
constexpr int LDS_BYTES = 147456;
constexpr float QSCALE = 0.18033688011112042f;

#define LAS __attribute__((address_space(3)))
typedef unsigned short bf16;
typedef unsigned v4u __attribute__((ext_vector_type(4)));
typedef unsigned v2u __attribute__((ext_vector_type(2)));
typedef float f32x4 __attribute__((ext_vector_type(4)));
typedef float f32x16 __attribute__((ext_vector_type(16)));
typedef short bf16x8 __attribute__((ext_vector_type(8)));
typedef short s16x4 __attribute__((ext_vector_type(4)));

__device__ __forceinline__ float bf2f(bf16 v) { return __uint_as_float(((unsigned)v) << 16); }
__device__ __forceinline__ float bflo(unsigned w) { return __uint_as_float(w << 16); }
__device__ __forceinline__ float bfhi(unsigned w) { return __uint_as_float(w & 0xffff0000u); }
__device__ __forceinline__ unsigned pk2(float lo, float hi) { return pg8::cvt_pk_bf16(lo, hi); }
__device__ __forceinline__ bf16 f2bf(float f) { return (bf16)(pk2(f, 0.f) & 0xffffu); }
__device__ __forceinline__ float wave_sum(float v) {
#pragma unroll
    for (int o = 1; o < 64; o <<= 1) v += __shfl_xor(v, o);
    return v;
}
__device__ __forceinline__ float wave_max(float v) {
#pragma unroll
    for (int o = 1; o < 64; o <<= 1) v = fmaxf(v, __shfl_xor(v, o));
    return v;
}
__device__ __forceinline__ float sigmoid_f(float x) { return 1.0f / (1.0f + __expf(-x)); }

__device__ __forceinline__ f32x4 unpk4(v2u w) { return (f32x4){bflo(w.x), bfhi(w.x), bflo(w.y), bfhi(w.y)}; }
__device__ __forceinline__ float sum4(f32x4 v) { return (v.x + v.y) + (v.z + v.w); }
struct Args { const float* in[19]; float* out; unsigned char* ws; int ph_lo, ph_hi; };

__device__ __forceinline__ void p0_transpose_item(const float* W, int K, int N, bf16* WT, LAS float* scr, int item, int lane) {
    const int nblk = N / 32, kb = item / nblk, nb = item % nblk, k0 = 64 * kb, n0 = 32 * nb;
#pragma unroll 8
    for (int i = 0; i < 32; ++i) { const int kk = 2 * i + (lane >> 5); scr[kk * 33 + (lane & 31)] = W[(size_t)(k0 + kk) * N + n0 + (lane & 31)]; }
    asm volatile("s_waitcnt lgkmcnt(0)" ::: "memory");
    const int c = lane & 7;
#pragma unroll
    for (int j = 0; j < 4; ++j) { const int n = (lane >> 3) + 8 * j; const LAS float* s = scr + (8 * c) * 33 + n;
        v4u o; o.x = pk2(s[0 * 33], s[1 * 33]); o.y = pk2(s[2 * 33], s[3 * 33]); o.z = pk2(s[4 * 33], s[5 * 33]); o.w = pk2(s[6 * 33], s[7 * 33]);
        *(v4u*)(WT + (size_t)(n0 + n) * K + k0 + 8 * c) = o; }
    asm volatile("s_waitcnt lgkmcnt(0)" ::: "memory");
}
__device__ __forceinline__ void rms_row_to_bf16(const float* xrow, const float* gain, bf16* orow, int lane) {
    const f32x4* xr = (const f32x4*)xrow + lane; const f32x4* gr = (const f32x4*)gain + lane;
    f32x4 v[8]; float s = 0.f;
#pragma unroll
    for (int j = 0; j < 8; ++j) { v[j] = xr[64 * j]; s += (v[j].x * v[j].x + v[j].y * v[j].y) + (v[j].z * v[j].z + v[j].w * v[j].w); }
    const float rstd = rsqrtf(wave_sum(s) * (1.f / DM) + 1e-6f);
    unsigned long long* o8 = (unsigned long long*)orow + lane;
#pragma unroll
    for (int j = 0; j < 8; ++j) { const f32x4 g = gr[64 * j];
        o8[64 * j] = (unsigned long long)pk2(v[j].x * rstd * g.x, v[j].y * rstd * g.y) | ((unsigned long long)pk2(v[j].z * rstd * g.z, v[j].w * rstd * g.w) << 32); }
}
__device__ __forceinline__ void p0_prologue(const Args& a, LAS unsigned char* lds, int tid, int wave, int lane) {
    LAS float* scr = (LAS float*)(lds + wave * 16384);
    const int gw = blockIdx.x * NWAVES + wave, NGW = gridDim.x * NWAVES;
    bf16* Win_t = (bf16*)(a.ws + WS_WIN); bf16* Wout_t = (bf16*)(a.ws + WS_WOUT); bf16* XN = (bf16*)a.out;
    constexpr int I_IN = (DM / 64) * (DIN / 32), I_OUT = (DM / 64) * (DM / 32);
    for (int it = gw; it < I_IN + I_OUT; it += NGW) {
        if (it < I_IN) p0_transpose_item(a.in[3], DM, DIN, Win_t, scr, it, lane);
        else p0_transpose_item(a.in[18], DM, DM, Wout_t, scr, it - I_IN, lane);
    }
    { v4u* z = (v4u*)(Win_t + (size_t)DIN * DM); const v4u zero = {0u, 0u, 0u, 0u};
      for (int i = blockIdx.x * NTHREADS + tid; i < (DINP - DIN) * DM * 2 / 16; i += gridDim.x * NTHREADS) z[i] = zero; }
    for (int m = gw; m < MTOK; m += NGW) {
        const float* xrow = m < 8192 ? a.in[0] + (size_t)m * DM : a.in[1] + (size_t)(m - 8192) * DM;
        rms_row_to_bf16(xrow, a.in[2], XN + (size_t)m * DM, lane);
    }
}

__device__ __forceinline__ float dpp_sum16(float v) {
    v += __builtin_bit_cast(float, __builtin_amdgcn_update_dpp(0, __builtin_bit_cast(int, v), 0xB1, 0xf, 0xf, true));
    v += __builtin_bit_cast(float, __builtin_amdgcn_update_dpp(0, __builtin_bit_cast(int, v), 0x4E, 0xf, 0xf, true));
    v += __builtin_bit_cast(float, __builtin_amdgcn_update_dpp(0, __builtin_bit_cast(int, v), 0x141, 0xf, 0xf, true));
    v += __builtin_bit_cast(float, __builtin_amdgcn_update_dpp(0, __builtin_bit_cast(int, v), 0x140, 0xf, 0xf, true));
    return v;
}
__device__ __forceinline__ float dpp_xor2(float v) { return __builtin_bit_cast(float, __builtin_amdgcn_update_dpp(0, __builtin_bit_cast(int, v), 0x4E, 0xf, 0xf, true)); }
__device__ __forceinline__ void attn_prep(const Args& a, LAS unsigned char* lds, int wave, int lane) {
    bf16* PROJ = (bf16*)(a.ws + WS_PROJ); bf16* VT = (bf16*)a.out;
    const int vec = lane >> 4, c16 = lane & 15;
    const f32x4 gain4 = *(const f32x4*)((vec < 2 ? a.in[14] : a.in[15]) + c16 * 4);
    const float oscale = vec < 2 ? QSCALE : 1.f;
    const int vcol = (vec < 2 ? C_QD : C_KD) + (vec & 1) * 64 + c16 * 4;
    f32x4 invf4;
#pragma unroll
    for (int j = 0; j < 4; ++j) invf4[j] = exp2f(-(float)((c16 & 1) * 4 + j) * 2.3664460711655218f) * 0.15915494309189535f;
    const float sgn = (c16 & 2) ? 1.f : -1.f;
    LAS unsigned char* tile = lds + wave * 16640;
    const int gw = blockIdx.x * NWAVES + wave, NGW = gridDim.x * NWAVES;
    for (int item = gw; item < 8 * 384; item += NGW) {
        const int hd = item / 384, gblk = item % 384, mb = gblk * 64;
        const int tpos0 = mb < 8192 ? mb : ((mb - 8192) & 2047);
#pragma unroll 2
        for (int tok = 0; tok < 64; ++tok) {
            bf16* p = PROJ + (size_t)(mb + tok) * DIN + hd * 128 + vcol;
            f32x4 x = unpk4(*(const v2u*)p);
            const float ss = dpp_sum16((x.x * x.x + x.y * x.y) + (x.z * x.z + x.w * x.w));
            x = x * (rsqrtf(ss * (1.f / 64) + 1e-6f) * oscale) * gain4;
            const float tf = (float)(tpos0 + tok);
            f32x4 xr;
#pragma unroll
            for (int j = 0; j < 4; ++j) { float rev = tf * invf4[j]; rev -= floorf(rev);
                const float cs = __builtin_amdgcn_cosf(rev), sn = __builtin_amdgcn_sinf(rev) * sgn;
                xr[j] = x[j] * cs + dpp_xor2(x[j]) * sn; }
            if (c16 < 4) x = xr;
            v2u w; w.x = pk2(x.x, x.y); w.y = pk2(x.z, x.w);
            *(v2u*)p = w;
        }
#pragma unroll 4
        for (int it = 0; it < 16; ++it) { const int id = it * 64 + lane, r = id >> 4, ch = id & 15;
            const v4u val = *(const v4u*)(PROJ + (size_t)(mb + r) * DIN + C_VD + hd * 128 + ch * 8);
            LAS unsigned* dst = (LAS unsigned*)(tile + r * 260 + ch * 16); dst[0] = val.x; dst[1] = val.y; dst[2] = val.z; dst[3] = val.w; }
        asm volatile("s_waitcnt lgkmcnt(0)" ::: "memory");
#pragma unroll 8
        for (int d = 0; d < 128; ++d) { const bf16 v = *(const LAS bf16*)(tile + lane * 260 + d * 2); VT[(size_t)(hd * 128 + d) * MTOK + mb + lane] = v; }
        asm volatile("s_waitcnt lgkmcnt(0)" ::: "memory");
    }
}

constexpr int TC = 32, ZSTR = 1040;
constexpr int LB_KK = 0, LB_WW = LB_KK + TC * 256, LB_BB = LB_WW + TC * 256, LB_KD = LB_BB + TC * 256, LB_RR = LB_KD + TC * 256, LB_VV = LB_RR + TC * 256, LB_OUT = LB_VV + TC * 256,
              LB_ZS = LB_OUT + TC * 256  , LB_RAW = LB_ZS + TC * ZSTR  , RAWB = (TC + 2) * 640, LB_MU = LB_RAW + 2 * RAWB, LB_END = LB_MU + 1280;
static_assert(LB_END <= LDS_BYTES - 64, "scan LDS");
typedef float f32x2v __attribute__((ext_vector_type(2)));
template <int LPR> __device__ __forceinline__ float dpp_sum_row(float v) {
    v += __builtin_bit_cast(float, __builtin_amdgcn_update_dpp(0, __builtin_bit_cast(int, v), 0xB1, 0xf, 0xf, true));
    v += __builtin_bit_cast(float, __builtin_amdgcn_update_dpp(0, __builtin_bit_cast(int, v), 0x4E, 0xf, 0xf, true));
    v += __builtin_bit_cast(float, __builtin_amdgcn_update_dpp(0, __builtin_bit_cast(int, v), 0x141, 0xf, 0xf, true));
    if (LPR == 16) v += __builtin_bit_cast(float, __builtin_amdgcn_update_dpp(0, __builtin_bit_cast(int, v), 0x140, 0xf, 0xf, true));
    return v;
}
__device__ __forceinline__ float fast_sigmoid(float x) { return __builtin_amdgcn_rcpf(1.0f + __expf(-x)); }
#define LDS_BARRIER() asm volatile("s_waitcnt lgkmcnt(0)\n\ts_barrier" ::: "memory")
template <int DIR, int RPW>
__device__ __forceinline__ void scan_unit(const Args& a, LAS unsigned char* lds, int seq, int h, int half, int tid_in) {
    constexpr int LPR = 64 / RPW, KS = RPW, NP = KS / 2, OSTR = 8 * RPW;
    int tid = tid_in; asm volatile("" : "+v"(tid));
    const int lane = tid & 63, wave = __builtin_amdgcn_readfirstlane(tid >> 6);
    const bf16* PROJ = (const bf16*)(a.ws + WS_PROJ);
    bf16* OD = (bf16*)((unsigned char*)a.out + (DIR ? DO_OB : DO_OF));
    const int m0 = seq == 0 ? 0 : 8192 + (seq - 1) * 2048, T = seq == 0 ? 8192 : 2048, nch = T / TC;
    const int rbase = RPW == 4 ? half * 32 : 0;
    const int sb_t = tid >> 4, c16 = tid & 15;
    if (tid < 320) { const int g = tid >> 6, c = tid & 63; const int gc = g < 3 ? g * 1024 + h * 64 + c : (g == 3 ? C_WD + c : C_AD + c); ((LAS float*)(lds + LB_MU))[tid] = a.in[4][gc]; }
    const f32x4 kk4c = *(const f32x4*)(a.in[9] + h * 64 + c16 * 4);
    const int mat = wave >> 2, nt4 = wave & 3, quad = lane >> 4, l15 = lane & 15, ncol = h * 64 + nt4 * 16 + l15;
    const float c0v = (mat == 0 ? a.in[5] : a.in[7])[DIR * 1024 + ncol], kav = a.in[10][ncol];
    bf16x8 bfr[2];
    { const float* UP = (mat == 0 ? a.in[6] : a.in[8]) + (size_t)DIR * 64 * 1024 + ncol;
#pragma unroll
      for (int ks = 0; ks < 2; ++ks) { float x[8];
#pragma unroll
          for (int j = 0; j < 8; ++j) x[j] = UP[(size_t)(ks * 32 + quad * 8 + j) * 1024];
          v4u p; p.x = pk2(x[0], x[1]); p.y = pk2(x[2], x[3]); p.z = pk2(x[4], x[5]); p.w = pk2(x[6], x[7]); bfr[ks] = __builtin_bit_cast(bf16x8, p); } }
    int crr[3], ccol[3], coff[3]; bool cval[3];
#pragma unroll
    for (int i = 0; i < 3; ++i) { const int ch = tid + 512 * i; cval[i] = ch < (TC + 2) * 40; const int rr = ch / 40, rem = ch % 40, g = rem >> 3, c8 = rem & 7;
        crr[i] = rr; ccol[i] = (g < 3 ? g * 1024 + h * 64 : (g == 3 ? C_WD : C_AD)) + c8 * 8; coff[i] = LB_RAW + rr * 640 + (g * 64 + c8 * 8) * 2; }
    f32x2v S[NP];
#pragma unroll
    for (int j = 0; j < NP; ++j) S[j] = (f32x2v){0.f, 0.f};
    const int rowl = lane / LPR, kq = lane % LPR, vrow = rbase + wave * RPW + rowl;
    const LAS unsigned char* opb = lds + kq * (KS * 4);
    const LAS unsigned char* vvb = lds + LB_VV + vrow * 4;
    LAS float* outp = (LAS float*)(lds + LB_OUT) + wave * RPW + rowl;
    v4u pre[3];
#define SCAN_LOAD(cc) do { const int t0_ = (DIR ? nch - 1 - (cc) : (cc)) * TC; _Pragma("unroll") for (int i = 0; i < 3; ++i) { const int t_ = t0_ - 1 + crr[i]; \
        const bool ok_ = cval[i] && t_ >= 0 && t_ < T; v4u z_ = {0u, 0u, 0u, 0u}; if (ok_) z_ = *(const v4u*)(PROJ + (size_t)(m0 + t_) * DIN + ccol[i]); pre[i] = z_; } } while (0)
#define SHIFT_GROUP(g, rawb) do { const LAS unsigned char* rp = lds + LB_RAW + (rawb) * RAWB + sb_t * 640 + ((g) * 64 + c16 * 4) * 2; \
        const v2u wp = *(const LAS v2u*)rp, wz = *(const LAS v2u*)(rp + 640), wn = *(const LAS v2u*)(rp + 1280); \
        const f32x4 mu4 = *(const LAS f32x4*)(lds + LB_MU + ((g) * 64 + c16 * 4) * 4); \
        const f32x4 z = unpk4(wz), zp = unpk4(wp), zn = unpk4(wn); \
        f32x4 zs = z + mu4 * (0.5f * (zp + zn) - z); \
        if ((g) == 3) { _Pragma("unroll") for (int j = 0; j < 4; ++j) zs[j] = 1.f - 2.f * __builtin_amdgcn_rcpf(__expf(2.f * zs[j]) + 1.f); } \
        *(LAS f32x4*)(lds + ((g) == 0 ? LB_RR + sb_t * 256 : (g) == 2 ? LB_VV + sb_t * 256 : LB_ZS + sb_t * ZSTR + ((g) == 1 ? 0 : (g) == 3 ? 256 : 512)) + c16 * 16) = zs; \
        if ((g) == 1) { const f32x4 kr = zs * kk4c; const float ss = dpp_sum_row<16>((kr.x * kr.x + kr.y * kr.y) + (kr.z * kr.z + kr.w * kr.w)); \
            *(LAS f32x4*)(lds + LB_ZS + sb_t * ZSTR + 768 + c16 * 16) = kr * rsqrtf(fmaxf(ss, 1e-12f)); } } while (0)
    SCAN_LOAD(0);
#pragma unroll
    for (int i = 0; i < 3; ++i) if (cval[i]) *(LAS v4u*)(lds + coff[i]) = pre[i];
    LDS_BARRIER();
    if (nch > 1) SCAN_LOAD(1);
    SHIFT_GROUP(1, 0); SHIFT_GROUP(3, 0); SHIFT_GROUP(4, 0);
    LDS_BARRIER();
#pragma nounroll
    for (int c = 0; c < nch; ++c) {
        const int cur = c & 1;
        if (c + 1 < nch) {
#pragma unroll
            for (int i = 0; i < 3; ++i) if (cval[i]) *(LAS v4u*)(lds + coff[i] + (cur ^ 1) * RAWB) = pre[i]; }
        if (c + 2 < nch) SCAN_LOAD(c + 2);
        SHIFT_GROUP(0, cur); SHIFT_GROUP(2, cur);
#pragma unroll
        for (int mt = 0; mt < 2; ++mt) { f32x4 acc = {0.f, 0.f, 0.f, 0.f};
#pragma unroll
            for (int ks = 0; ks < 2; ++ks) { const LAS unsigned char* ap = lds + LB_ZS + (mt * 16 + l15) * ZSTR + (64 + mat * 64 + ks * 32 + quad * 8) * 4;
                const f32x4 x0 = *(const LAS f32x4*)ap, x1 = *(const LAS f32x4*)(ap + 16);
                v4u p; p.x = pk2(x0.x, x0.y); p.y = pk2(x0.z, x0.w); p.z = pk2(x1.x, x1.y); p.w = pk2(x1.z, x1.w);
                acc = __builtin_amdgcn_mfma_f32_16x16x32_bf16(__builtin_bit_cast(bf16x8, p), bfr[ks], acc, 0, 0, 0); }
#pragma unroll
            for (int j = 0; j < 4; ++j) { const int t = mt * 16 + quad * 4 + j, n = nt4 * 16 + l15; const float sg = fast_sigmoid(acc[j] + c0v);
                if (mat == 0) *(LAS float*)(lds + LB_WW + t * 256 + n * 4) = __expf(-0.606531f * sg);
                else { const float kv = *(const LAS float*)(lds + LB_ZS + t * ZSTR + n * 4), kkv = *(const LAS float*)(lds + LB_ZS + t * ZSTR + 768 + n * 4);
                    *(LAS float*)(lds + LB_KD + t * 256 + n * 4) = kv * (1.f + (sg - 1.f) * kav); *(LAS float*)(lds + LB_BB + t * 256 + n * 4) = sg * kkv; *(LAS float*)(lds + LB_KK + t * 256 + n * 4) = kkv; } } }
        if (c > 0 && tid < TC * RPW) { const int t0p = (DIR ? nch - c : c - 1) * TC;
            const int t = tid / RPW, q8 = tid % RPW; const LAS float* o = (const LAS float*)(lds + LB_OUT) + t * OSTR + q8 * 8;
            v4u w; w.x = pk2(o[0], o[1]); w.y = pk2(o[2], o[3]); w.z = pk2(o[4], o[5]); w.w = pk2(o[6], o[7]);
            *(v4u*)(OD + (size_t)(m0 + t0p + t) * 1024 + h * 64 + rbase + q8 * 8) = w; }
        LDS_BARRIER();
        {
#define SC_LD(tt, KK2, W2, B2, KD2, R2, VV) do { _Pragma("unroll") for (int q_ = 0; q_ < NP; ++q_) { KK2[q_] = *(const LAS f32x2v*)(gb + LB_KK + (tt) * 256 + q_ * 8); W2[q_] = *(const LAS f32x2v*)(gb + LB_WW + (tt) * 256 + q_ * 8); \
            B2[q_] = *(const LAS f32x2v*)(gb + LB_BB + (tt) * 256 + q_ * 8); KD2[q_] = *(const LAS f32x2v*)(gb + LB_KD + (tt) * 256 + q_ * 8); R2[q_] = *(const LAS f32x2v*)(gb + LB_RR + (tt) * 256 + q_ * 8); } VV = *(const LAS float*)(gv + (tt) * 256); } while (0)
            f32x2v kk2[NP], w2[NP], b2[NP], kd2[NP], r2[NP]; float vv;
            { const int tf = DIR ? TC - 1 : 0; const LAS unsigned char* gb = opb + tf * 256; const LAS unsigned char* gv = vvb + tf * 256; SC_LD(0, kk2, w2, b2, kd2, r2, vv); }
#pragma nounroll
            for (int so = 0; so < 4; ++so) {
                constexpr int bias = DIR ? 1 : 0;
                const int tbase = (DIR ? TC - 8 - 8 * so : 8 * so) - bias;
                const LAS unsigned char* gb = opb + tbase * 256; const LAS unsigned char* gv = vvb + tbase * 256;
                LAS float* go = outp + tbase * OSTR;
#pragma unroll
                for (int j = 0; j < 8; ++j) { const int tj = (DIR ? 7 - j : j) + bias, tn = DIR ? tj - 1 : tj + 1;
                    f32x2v nkk2[NP], nw2[NP], nb2[NP], nkd2[NP], nr2[NP]; float nvv = vv;
#pragma unroll
                    for (int q = 0; q < NP; ++q) { nkk2[q] = kk2[q]; nw2[q] = w2[q]; nb2[q] = b2[q]; nkd2[q] = kd2[q]; nr2[q] = r2[q]; }
                    if (j < 7 || so < 3) SC_LD(tn, nkk2, nw2, nb2, nkd2, nr2, nvv);
                    f32x2v acc = S[0] * kk2[0];
#pragma unroll
                    for (int q = 1; q < NP; ++q) acc = S[q] * kk2[q] + acc;
                    const float sa = -dpp_sum_row<LPR>(acc.x + acc.y);
                    const f32x2v sa2 = {sa, sa}, vv2 = {vv, vv};
#pragma unroll
                    for (int q = 0; q < NP; ++q) S[q] = S[q] * w2[q] + (vv2 * kd2[q] + sa2 * b2[q]);
                    f32x2v oc = S[0] * r2[0];
#pragma unroll
                    for (int q = 1; q < NP; ++q) oc = S[q] * r2[q] + oc;
                    go[tj * OSTR] = dpp_sum_row<LPR>(oc.x + oc.y);
                    vv = nvv;
#pragma unroll
                    for (int q = 0; q < NP; ++q) { kk2[q] = nkk2[q]; w2[q] = nw2[q]; b2[q] = nb2[q]; kd2[q] = nkd2[q]; r2[q] = nr2[q]; }
                }
            }
#undef SC_LD
        }
        if (c + 1 < nch) { SHIFT_GROUP(1, cur ^ 1); SHIFT_GROUP(3, cur ^ 1); SHIFT_GROUP(4, cur ^ 1); }
        LDS_BARRIER();
    }
    if (tid < TC * RPW) { const int t0p = (DIR ? 0 : nch - 1) * TC;
        const int t = tid / RPW, q8 = tid % RPW; const LAS float* o = (const LAS float*)(lds + LB_OUT) + t * OSTR + q8 * 8;
        v4u w; w.x = pk2(o[0], o[1]); w.y = pk2(o[2], o[3]); w.z = pk2(o[4], o[5]); w.w = pk2(o[6], o[7]);
        *(v4u*)(OD + (size_t)(m0 + t0p + t) * 1024 + h * 64 + rbase + q8 * 8) = w; }
#undef SHIFT_GROUP
#undef SCAN_LOAD
}

constexpr int QSTR = 272, KSTR = 144, VSTR = 136;
constexpr int A_QOFF = 0, A_KOFF = 256 * QSTR, A_KBUF = 64 * KSTR, A_VOFF = A_KOFF + 2 * A_KBUF, A_VBUF = 128 * VSTR, A_END = A_VOFF + 2 * A_VBUF;
static_assert(A_END <= LDS_BYTES - 64, "attention LDS");
#define MFMA32(a_, b_, c_) __builtin_amdgcn_mfma_f32_32x32x16_bf16((a_), (b_), (c_), 0, 0, 0)
__device__ __forceinline__ bf16x8 pack8(const f32x16& p, int b) {
    v4u w; w.x = pk2(p[b], p[b + 1]); w.y = pk2(p[b + 2], p[b + 3]); w.z = pk2(p[b + 4], p[b + 5]); w.w = pk2(p[b + 6], p[b + 7]); return __builtin_bit_cast(bf16x8, w);
}
__device__ __forceinline__ void attn_qk(f32x16& p0, f32x16& p1, const LAS unsigned char* qrow, const LAS unsigned char* Kb, const f32x16& negm) {
#pragma unroll
    for (int s = 0; s < 4; ++s) {
        const bf16x8 qf = *(const LAS bf16x8*)(qrow + s * 32);
        const bf16x8 a0 = *(const LAS bf16x8*)(Kb + s * 32), a1 = *(const LAS bf16x8*)(Kb + 32 * KSTR + s * 32);
        if (s == 0) { p0 = MFMA32(a0, qf, negm); p1 = MFMA32(a1, qf, negm); }
        else { p0 = MFMA32(a0, qf, p0); p1 = MFMA32(a1, qf, p1); }
    }
}
__device__ __forceinline__ void attn_exp(f32x16& p0, f32x16& p1, float M2, float& lsum, bf16x8 (&pf)[4]) {
    float ls = 0.f;
#pragma unroll
    for (int r = 0; r < 16; ++r) { p0[r] = __builtin_amdgcn_exp2f(p0[r]); p1[r] = __builtin_amdgcn_exp2f(p1[r]); ls += p0[r] + p1[r]; }
    lsum += ls;
    pf[0] = pack8(p0, 0); pf[1] = pack8(p0, 8); pf[2] = pack8(p1, 0); pf[3] = pack8(p1, 8);
}
__device__ __forceinline__ void attn_pv(f32x16 (&o)[4], const LAS unsigned char* Vb, const bf16x8 (&pf)[4]) {
    s16x4 lo[4], hi[4];
#pragma unroll
    for (int s2 = 0; s2 < 4; ++s2) { lo[s2] = *(const LAS s16x4*)(Vb + s2 * 32); hi[s2] = *(const LAS s16x4*)(Vb + s2 * 32 + 16); }
#pragma unroll
    for (int db = 0; db < 4; ++db) {
        s16x4 nlo[4], nhi[4];
#pragma unroll
        for (int s2 = 0; s2 < 4; ++s2) { nlo[s2] = lo[s2]; nhi[s2] = hi[s2]; }
        if (db < 3) {
#pragma unroll
            for (int s2 = 0; s2 < 4; ++s2) { nlo[s2] = *(const LAS s16x4*)(Vb + (db + 1) * 32 * VSTR + s2 * 32); nhi[s2] = *(const LAS s16x4*)(Vb + (db + 1) * 32 * VSTR + s2 * 32 + 16); } }
        __builtin_amdgcn_sched_barrier(0);
#pragma unroll
        for (int s2 = 0; s2 < 4; ++s2) o[db] = MFMA32(__builtin_shufflevector(lo[s2], hi[s2], 0, 1, 2, 3, 4, 5, 6, 7), pf[s2], o[db]);
        __builtin_amdgcn_sched_barrier(0);
#pragma unroll
        for (int s2 = 0; s2 < 4; ++s2) { lo[s2] = nlo[s2]; hi[s2] = nhi[s2]; }
    }
}
__device__ __forceinline__ void attn_unit(const Args& a, LAS unsigned char* lds, int seq, int hd, int qblk, int tid_in, float M2, float lam) {
    int tid = tid_in; asm volatile("" : "+v"(tid));
    const int lane = tid & 63, wave = __builtin_amdgcn_readfirstlane(tid >> 6);
    const bf16* PROJ = (const bf16*)(a.ws + WS_PROJ); const bf16* VT = (const bf16*)a.out; bf16* CONCAT = (bf16*)(a.ws + WS_CONCAT);
    const int m0 = seq == 0 ? 0 : 8192 + (seq - 1) * 2048, T = seq == 0 ? 8192 : 2048, nkt = T / 64;
    const int i = lane & 31, hh = lane >> 5;
    const int mq0 = m0 + qblk * 256 + wave * 32;
#pragma unroll
    for (int it = 0; it < 8; ++it) { const int id = it * 64 + lane, r = id >> 4, ch = id & 15;
        const v4u v = *(const v4u*)(PROJ + (size_t)(mq0 + r) * DIN + C_QD + hd * 128 + ch * 8);
        *(LAS v4u*)(lds + A_QOFF + (wave * 32 + r) * QSTR + ch * 16) = v; }
    const bf16* vsrc[2]; int vdst[2];
#pragma unroll
    for (int j = 0; j < 2; ++j) { const int id = tid + 512 * j, d = id >> 3, ch = id & 7; vsrc[j] = VT + (size_t)(hd * 128 + d) * MTOK + m0 + ch * 8; vdst[j] = A_VOFF + d * VSTR + ch * 16; }
    const int kdst = A_KOFF + (tid >> 3) * KSTR + (tid & 7) * 16;
    const int qoff = A_QOFF + (wave * 32 + i) * QSTR + hh * 16;
    f32x16 negm;
#pragma unroll
    for (int r = 0; r < 16; ++r) negm[r] = -M2;
    asm volatile("" : "+v"(negm));
    v4u* const stash = (v4u*)(a.ws + WS_END) + ((size_t)blockIdx.x * NTHREADS + tid_in) * 8;
#pragma nounroll
    for (int c = 0; c < 2; ++c) {
        const bf16* ksrc = PROJ + (size_t)(m0 + (tid >> 3)) * DIN + C_KD + hd * 128 + c * 64 + (tid & 7) * 8;
        v4u kreg, vreg[2];
        kreg = *(const v4u*)ksrc;
#pragma unroll
        for (int j = 0; j < 2; ++j) vreg[j] = *(const v4u*)vsrc[j];
        *(LAS v4u*)(lds + kdst) = kreg;
#pragma unroll
        for (int j = 0; j < 2; ++j) { *(LAS v2u*)(lds + vdst[j]) = (v2u){vreg[j].x, vreg[j].y}; *(LAS v2u*)(lds + vdst[j] + 8) = (v2u){vreg[j].z, vreg[j].w}; }
        kreg = *(const v4u*)(ksrc + (size_t)64 * DIN);
        *(LAS v4u*)(lds + kdst + A_KBUF) = kreg;
        LDS_BARRIER();
        f32x16 o[4];
#pragma unroll
        for (int db = 0; db < 4; ++db)
#pragma unroll
            for (int r = 0; r < 16; ++r) o[db][r] = 0.f;
        float lsum = 0.f;
        f32x16 pn0, pn1;
        attn_qk(pn0, pn1, lds + qoff + c * 128, lds + A_KOFF + i * KSTR + hh * 16, negm);
#pragma nounroll
        for (int kt = 0; kt < nkt; ++kt) {
            const int cur = kt & 1;
            int qo = qoff + c * 128; asm volatile("" : "+v"(qo));
            const LAS unsigned char* qrow = lds + qo;
            if (kt + 2 < nkt) kreg = *(const v4u*)(ksrc + (size_t)(kt + 2) * 64 * DIN);
            if (kt + 1 < nkt) {
#pragma unroll
                for (int j = 0; j < 2; ++j) vreg[j] = *(const v4u*)(vsrc[j] + (kt + 1) * 64); }
            f32x16 pc0 = pn0, pc1 = pn1;
            attn_qk(pn0, pn1, qrow, lds + A_KOFF + (cur ^ 1) * A_KBUF + i * KSTR + hh * 16, negm);
            bf16x8 pf[4];
            attn_exp(pc0, pc1, M2, lsum, pf);
#pragma unroll
            for (int g = 0; g < 8; ++g) { __builtin_amdgcn_sched_group_barrier(0x008, 1, 0); __builtin_amdgcn_sched_group_barrier(0x002, 14, 0); }
            __builtin_amdgcn_sched_barrier(0);
            attn_pv(o, lds + A_VOFF + cur * A_VBUF + i * VSTR + hh * 8, pf);
            if (kt + 2 < nkt) *(LAS v4u*)(lds + kdst + cur * A_KBUF) = kreg;
            if (kt + 1 < nkt) {
#pragma unroll
                for (int j = 0; j < 2; ++j) { *(LAS v2u*)(lds + vdst[j] + (cur ^ 1) * A_VBUF) = (v2u){vreg[j].x, vreg[j].y}; *(LAS v2u*)(lds + vdst[j] + (cur ^ 1) * A_VBUF + 8) = (v2u){vreg[j].z, vreg[j].w}; } }
            LDS_BARRIER();
        }
        const float l = lsum + __shfl_xor(lsum, 32);
        if (c == 0) {
            const float i0 = 1.f / l;
#pragma unroll
            for (int db = 0; db < 4; ++db) {
                __builtin_amdgcn_sched_barrier(0);
                v4u w0, w1;
                w0.x = pk2(o[db][0] * i0, o[db][1] * i0); w0.y = pk2(o[db][2] * i0, o[db][3] * i0); w0.z = pk2(o[db][4] * i0, o[db][5] * i0); w0.w = pk2(o[db][6] * i0, o[db][7] * i0);
                w1.x = pk2(o[db][8] * i0, o[db][9] * i0); w1.y = pk2(o[db][10] * i0, o[db][11] * i0); w1.z = pk2(o[db][12] * i0, o[db][13] * i0); w1.w = pk2(o[db][14] * i0, o[db][15] * i0);
                stash[db * 2] = w0; stash[db * 2 + 1] = w1; }
        } else {
            int tid2 = tid_in; asm volatile("" : "+v"(tid2));
            const int i_e = tid2 & 31, hh_e = (tid2 >> 5) & 1, wave_e = __builtin_amdgcn_readfirstlane(tid2 >> 6);
            const float i1 = lam / l;
            float ss = 0.f;
#pragma unroll
            for (int db = 0; db < 4; ++db) {
                __builtin_amdgcn_sched_barrier(0);
                const v4u w0 = stash[db * 2], w1 = stash[db * 2 + 1];
                const unsigned ww[8] = {w0.x, w0.y, w0.z, w0.w, w1.x, w1.y, w1.z, w1.w};
#pragma unroll
                for (int r = 0; r < 16; r += 2) { const unsigned w = ww[r >> 1];
                    const float v0 = bflo(w) - o[db][r] * i1, v1 = bfhi(w) - o[db][r + 1] * i1; o[db][r] = v0; o[db][r + 1] = v1; ss = __builtin_fmaf(v0, v0, ss); ss = __builtin_fmaf(v1, v1, ss); } }
            __builtin_amdgcn_sched_barrier(0);
            ss += __shfl_xor(ss, 32);
            const float rs = rsqrtf(ss * (1.f / 128) + 1e-6f) * 0.8f;
            const size_t mq = (size_t)(m0 + qblk * 256 + wave_e * 32 + i_e);
#pragma unroll
            for (int db = 0; db < 4; ++db)
#pragma unroll
                for (int g = 0; g < 4; ++g) { const int d0 = 32 * db + 8 * g + 4 * hh_e;
                    __builtin_amdgcn_sched_barrier(0);
                    const v2u gw2 = *(const v2u*)(PROJ + mq * DIN + C_GD + hd * 128 + d0); const f32x4 sg4 = *(const f32x4*)(a.in[17] + d0);
                    const float g0 = bflo(gw2.x), g1 = bfhi(gw2.x), g2 = bflo(gw2.y), g3 = bfhi(gw2.y);
                    const float y0 = o[db][4 * g + 0] * rs * sg4.x * g0 * sigmoid_f(g0), y1 = o[db][4 * g + 1] * rs * sg4.y * g1 * sigmoid_f(g1),
                                y2 = o[db][4 * g + 2] * rs * sg4.z * g2 * sigmoid_f(g2), y3 = o[db][4 * g + 3] * rs * sg4.w * g3 * sigmoid_f(g3);
                    v2u w; w.x = pk2(y0, y1); w.y = pk2(y2, y3); *(v2u*)(CONCAT + mq * DM + 1024 + hd * 128 + d0) = w; }
        }
    }
}

__device__ __forceinline__ void rwkv_post(const Args& a, int wave, int lane) {
    const bf16* PROJ = (const bf16*)(a.ws + WS_PROJ); bf16* CONCAT = (bf16*)(a.ws + WS_CONCAT);
    const bf16* OF = (const bf16*)((unsigned char*)a.out + DO_OF); const bf16* OB = (const bf16*)((unsigned char*)a.out + DO_OB);
    const int gw = blockIdx.x * NWAVES + wave, NGW = gridDim.x * NWAVES;
    const int hg = gw & 3, col = (hg * 4 + (lane >> 4)) * 64 + (lane & 15) * 4;
    const f32x4 mu_r = *(const f32x4*)(a.in[4] + col), mu_k = *(const f32x4*)(a.in[4] + 1024 + col), mu_v = *(const f32x4*)(a.in[4] + 2048 + col);
    const f32x4 rk4 = *(const f32x4*)(a.in[11] + col), gg4 = *(const f32x4*)(a.in[12] + col), gb4 = *(const f32x4*)(a.in[13] + col);
    for (int m = gw >> 2; m < MTOK; m += NGW >> 2) {
        const int tpos = m < 8192 ? m : ((m - 8192) & 2047), T = m < 8192 ? 8192 : 2048;
        const float fp = tpos > 0 ? 0.5f : 0.f, fn = tpos < T - 1 ? 0.5f : 0.f;
        const int dp = tpos > 0 ? -DIN : 0, dn = tpos < T - 1 ? DIN : 0;
        const f32x4 of = unpk4(*(const v2u*)(OF + (size_t)m * 1024 + col)) + unpk4(*(const v2u*)(OB + (size_t)m * 1024 + col));
        const bf16* row = PROJ + (size_t)m * DIN + col;
        const f32x4 r0 = unpk4(*(const v2u*)row), rp = unpk4(*(const v2u*)(row + dp)), rn = unpk4(*(const v2u*)(row + dn));
        const f32x4 k0 = unpk4(*(const v2u*)(row + C_K)), kp = unpk4(*(const v2u*)(row + C_K + dp)), kn = unpk4(*(const v2u*)(row + C_K + dn));
        const f32x4 v0 = unpk4(*(const v2u*)(row + C_V)), vp = unpk4(*(const v2u*)(row + C_V + dp)), vn = unpk4(*(const v2u*)(row + C_V + dn));
        const f32x4 g = unpk4(*(const v2u*)(row + C_GR));
        const float mean = dpp_sum_row<16>(sum4(of)) * (1.f / 64);
        const f32x4 dv = of - mean;
        const float var = dpp_sum_row<16>(sum4(dv * dv)) * (1.f / 64);
        const f32x4 on = dv * rsqrtf(var + 64e-5f) * gg4 + gb4;
        const f32x4 rs = r0 + mu_r * (fp * rp + fn * rn - r0), ks = k0 + mu_k * (fp * kp + fn * kn - k0), vs = v0 + mu_v * (fp * vp + fn * vn - v0);
        const float bsum = dpp_sum_row<16>(sum4(rs * ks * rk4));
        f32x4 y = on + bsum * vs;
#pragma unroll
        for (int j = 0; j < 4; ++j) y[j] = y[j] * g[j] * fast_sigmoid(g[j]);
        v2u w; w.x = pk2(y.x, y.y); w.y = pk2(y.z, y.w);
        *(v2u*)(CONCAT + (size_t)m * DM + col) = w;
    }
}

constexpr int LDS_ARGS = LDS_BYTES - 512, LDS_XB = LDS_BYTES - 48;
constexpr int CW_BAR = 4096;
__device__ __forceinline__ const void* lds_arg_ptr(LAS unsigned char* lds, int k) {
    const v2u w = *(const LAS v2u*)(lds + LDS_ARGS + 8 * k);
    const unsigned lo = __builtin_amdgcn_readfirstlane(w.x), hi = __builtin_amdgcn_readfirstlane(w.y);
    return (const void*)(__attribute__((address_space(1))) const void*)(((unsigned long long)hi << 32) | lo);
}
#define LOAD_ARGS(la) Args la; do { _Pragma("unroll") for (int k_ = 0; k_ < 19; ++k_) la.in[k_] = (const float*)lds_arg_ptr(lds, k_); \
    la.out = (float*)lds_arg_ptr(lds, 19); la.ws = (unsigned char*)lds_arg_ptr(lds, 20); la.ph_lo = 0; la.ph_hi = 0; } while (0)

#define XB_TMO      128
#define XB_XCNT(j)  (256  + 64 * (j))
#define XB_XSUB(j)  (1280 + 64 * (j))
#define XB_XGEN(j)  (2304 + 64 * (j))
#define XB_TOP      3328
#define XB_TOPGEN   3392
#define XCD_BAR_WORDS 3456
#define XB_SPIN_CAP (1u << 18)

__device__ __forceinline__ unsigned xb_ld(unsigned* p)              { return __hip_atomic_load(p, __ATOMIC_RELAXED, __HIP_MEMORY_SCOPE_AGENT); }
__device__ __forceinline__ unsigned xb_add(unsigned* p, unsigned v) { return __hip_atomic_fetch_add(p, v, __ATOMIC_RELAXED, __HIP_MEMORY_SCOPE_AGENT); }
__device__ __forceinline__ unsigned xb_xcc_id() { return (unsigned)__builtin_amdgcn_s_getreg((3 << 11) | 20) & 0xFu; }
#define XB_SPIN(cond, bar) do { unsigned _sp = 0; while (cond) { __builtin_amdgcn_s_sleep(1); \
    if ((++_sp & 255u) == 0u) { if (xb_ld(&(bar)[XB_TMO])) break; if (_sp > XB_SPIN_CAP) { atomicAdd(&(bar)[XB_TMO], 1u); break; } } } } while (0)

struct XcdBarrier {
    unsigned* bar; unsigned x;
    volatile LAS unsigned* st;
};

__device__ __forceinline__ XcdBarrier xcd_barrier_post(unsigned* bar, volatile LAS unsigned* st) {
    XcdBarrier b; b.bar = bar; b.x = xb_xcc_id(); b.st = st;
    if (threadIdx.x == 0) (void)xb_add(&bar[XB_XCNT(b.x)], 1u);
    return b;
}
__device__ __forceinline__ void xcd_barrier_complete(unsigned* bar, unsigned x, unsigned& nloc, unsigned& nx) {
    const unsigned G = gridDim.x * gridDim.y * gridDim.z;
    unsigned sum, cnt, mine, sp = 0u;
    for (;;) {
        sum = 0u; cnt = 0u; mine = 0u;
#pragma unroll
        for (unsigned j = 0; j < 16; ++j) { const unsigned c = xb_ld(&bar[XB_XCNT(j)]); sum += c; cnt += (c > 0u) ? 1u : 0u; mine = (j == x) ? c : mine; }
        if (sum == G) break;
        __builtin_amdgcn_s_sleep(1);
        if ((++sp & 255u) == 0u) { if (xb_ld(&bar[XB_TMO])) break; if (sp > XB_SPIN_CAP) { atomicAdd(&bar[XB_TMO], 1u); break; } }
    }
    nloc = mine > 0u ? mine : 1u; nx = cnt > 0u ? cnt : 1u;
}

__device__ __forceinline__ void xcd_barrier(const XcdBarrier& b) {
    asm volatile("s_waitcnt vmcnt(0)" ::: "memory");
    __syncthreads();
    if (threadIdx.x == 0) {
        unsigned* bar = b.bar;
        __builtin_amdgcn_s_waitcnt(0);
        unsigned nloc = b.st[0], nx = b.st[1];
        if (nloc == 0u) { xcd_barrier_complete(bar, b.x, nloc, nx); b.st[0] = nloc; b.st[1] = nx; }
        const unsigned old = xb_add(&bar[XB_XSUB(b.x)], 1u);
        const unsigned gen = old / nloc;
        if (old + 1u == (gen + 1u) * nloc) {
            __builtin_amdgcn_fence(__ATOMIC_RELEASE, "agent");
            asm volatile("s_waitcnt vmcnt(0)" ::: "memory");
            const unsigned og = xb_add(&bar[XB_TOP], 1u);
            const unsigned tg = og / nx;
            if (og + 1u == (tg + 1u) * nx) xb_add(&bar[XB_TOPGEN], 1u);
            else XB_SPIN(xb_ld(&bar[XB_TOPGEN]) == tg, bar);
            __builtin_amdgcn_fence(__ATOMIC_ACQUIRE, "agent");
            xb_add(&bar[XB_XGEN(b.x)], 1u);
            asm volatile("s_waitcnt vmcnt(0)" ::: "memory");
        } else {
            XB_SPIN(xb_ld(&bar[XB_XGEN(b.x)]) == gen, bar);
            __builtin_amdgcn_fence(__ATOMIC_ACQUIRE, "agent");
            asm volatile("s_waitcnt vmcnt(0)" ::: "memory");
        }
    }
    __syncthreads();
}

__global__ void __launch_bounds__(NTHREADS, 2) hymba_fwd(Args a) {
    extern __shared__ __attribute__((aligned(16))) unsigned char lds_raw[];
    LAS unsigned char* lds = (LAS unsigned char*)lds_raw;
    const int tid = threadIdx.x, lane = tid & 63, wave = __builtin_amdgcn_readfirstlane(tid >> 6);
    const int lo = a.ph_lo, hi = a.ph_hi;
    if (tid < 21) { const unsigned long long v = tid < 19 ? (unsigned long long)a.in[tid < 19 ? tid : 0] : (tid == 19 ? (unsigned long long)a.out : (unsigned long long)a.ws); *(LAS unsigned long long*)(lds + LDS_ARGS + 8 * tid) = v; }
    if (tid < 2) *(LAS unsigned*)(lds + LDS_XB + 4 * tid) = 0u;
    __syncthreads();
    const XcdBarrier xbar = xcd_barrier_post((unsigned*)(a.ws + WS_CTL) + CW_BAR, (volatile LAS unsigned*)(lds + LDS_XB));
#define IN(k) (lo <= (k) && (k) < hi)
#define SEAM(k) do { if (IN(k) && IN((k) + 1)) { if ((k) == 0) cg::this_grid().sync(); else xcd_barrier(xbar); } } while (0)
        if (IN(0)) { p0_prologue(a, lds, tid, wave, lane); }
    SEAM(0);
    if (IN(1)) {
        pg8::Gemm g{(const pg8::bf16_t*)a.out, (const pg8::bf16_t*)(a.ws + WS_WIN), MTOK, DINP, DM}; pg8::StaticOrder S; S.init(MTOK, DINP, (int)gridDim.x, (int)blockIdx.x);
        pg8::EpiBf16 E{(pg8::bf16_t*)(a.ws + WS_PROJ), DIN, DIN};
        pg8::gemm_phase<pg8::EpiBf16, pg8::StaticOrder, true, true>(lds, g, S, E);
    }
    SEAM(1);
    if (IN(2)) { LOAD_ARGS(la); attn_prep(la, lds, wave, lane); }
    SEAM(2);
constexpr int UNITS_PER_PART = 8 + 32 + 32 + 64;
#define RUN_QUEUE(CBASE) do { \
        LAS unsigned* qslot = (LAS unsigned*)(lds + LDS_BYTES - 16); \
        const int p0_ = (int)(__builtin_amdgcn_s_getreg((3 << 11) | 20) & 7u); \
        for (int pi = 0; pi < 8; ++pi) { \
            const int p = (p0_ + pi) & 7; \
            unsigned* ctr = (unsigned*)(la.ws + WS_CTL) + 64 * ((CBASE) + p); \
            for (;;) { \
                if (tid == 0) *qslot = atomicAdd(ctr, 1u); \
                __syncthreads(); \
                const int li = (int)*qslot; \
                __syncthreads(); \
                if (li >= UNITS_PER_PART) break; \
                if (li < 8) { const int u = p * 8 + li; if ((u >> 1) & 1) scan_unit<1, 4>(la, lds, 0, u >> 2, u & 1, tid); else scan_unit<0, 4>(la, lds, 0, u >> 2, u & 1, tid); } \
                else if (li < 40) { attn_unit(la, lds, 0, p, li - 8, tid, M2u, lamu); } \
                else if (li < 72) { const int v = p * 32 + (li - 40), r = v & 31; if (r & 1) scan_unit<1, 8>(la, lds, 1 + (v >> 5), r >> 1, 0, tid); else scan_unit<0, 8>(la, lds, 1 + (v >> 5), r >> 1, 0, tid); } \
                else { const int j = li - 72; attn_unit(la, lds, 1 + (j >> 3), p, j & 7, tid, M2u, lamu); } \
            } } } while (0)
    if (IN(3)) {
        LOAD_ARGS(la);
        const float M2u = __builtin_bit_cast(float, __builtin_amdgcn_readfirstlane(__builtin_bit_cast(int, 11.6f * wave_max(fabsf(la.in[14][lane])) * wave_max(fabsf(la.in[15][lane])))));
        const float lamu = __builtin_bit_cast(float, __builtin_amdgcn_readfirstlane(__builtin_bit_cast(int, __expf(wave_sum(la.in[16][lane] * la.in[16][64 + lane])) - __expf(wave_sum(la.in[16][128 + lane] * la.in[16][192 + lane])) + 0.2f)));
        RUN_QUEUE(1);
    }
    SEAM(3);
    if (IN(4)) { LOAD_ARGS(la); rwkv_post(la, wave, lane); }
    SEAM(4);
    if (IN(5)) {
        LOAD_ARGS(la);
        pg8::Gemm g{(const pg8::bf16_t*)(la.ws + WS_CONCAT), (const pg8::bf16_t*)(la.ws + WS_WOUT), MTOK, DM, DM}; pg8::StaticOrder S; S.init(MTOK, DM, (int)gridDim.x, (int)blockIdx.x);
        pg8::EpiResF32 E{la.in[0], la.in[1], la.out};
        pg8::gemm_phase<pg8::EpiResF32, pg8::StaticOrder, true, true>(lds, g, S, E);
    }
#undef IN
#undef SEAM
}

extern "C" void kernel_launch(void* const* d_in, const int* in_sizes, int n_in, void* d_out, int out_size, void* d_ws, size_t ws_size, hipStream_t stream) {
    static int grid = 0;
    if (grid == 0) {
        if (n_in != 19 || out_size != MTOK * DM || ws_size < WS_TOTAL) { fprintf(stderr, "kernel_launch: unexpected shapes: n_in %d out %d ws %zu\n", n_in, out_size, ws_size); grid = -1; return; }
        int dev = 0, cus = 0, per_cu = 0;
        (void)hipGetDevice(&dev); (void)hipDeviceGetAttribute(&cus, hipDeviceAttributeMultiprocessorCount, dev);
        (void)hipFuncSetAttribute((const void*)hymba_fwd, hipFuncAttributeMaxDynamicSharedMemorySize, LDS_BYTES);
        (void)hipOccupancyMaxActiveBlocksPerMultiprocessor(&per_cu, (const void*)hymba_fwd, NTHREADS, LDS_BYTES);
        if (per_cu < 1) per_cu = 1;
        (void)hipGetLastError();
        grid = cus * per_cu;
        if (grid <= 0 || grid > 256) grid = 256;
    }
    if (grid < 0) return;
    (void)hipMemsetAsync((char*)d_ws + WS_CTL, 0, 65536, stream);
    Args a{};
    for (int i = 0; i < 19; ++i) a.in[i] = (const float*)d_in[i];
    a.out = (float*)d_out; a.ws = (unsigned char*)d_ws;
#if MK_N_LAUNCHES == 1
    a.ph_lo = 0; a.ph_hi = 6;
    void* args[] = {&a};
    hipError_t e = hipLaunchCooperativeKernel((const void*)hymba_fwd, dim3(grid), dim3(NTHREADS), args, LDS_BYTES, stream);
    if (e != hipSuccess) fprintf(stderr, "cooperative launch failed: %s (grid %d)\n", hipGetErrorString(e), grid);
#else
    for (int p = 0; p < 6; ++p) { a.ph_lo = p; a.ph_hi = p + 1; hipLaunchKernelGGL(hymba_fwd, dim3(grid), dim3(NTHREADS), LDS_BYTES, stream, a); }
#endif
}
```

```cpp
#include <hip/hip_runtime.h>
#include <hip/hip_cooperative_groups.h>
#include <cstdio>
#include <cstdint>
namespace cg = cooperative_groups;
#define MK_N_LAUNCHES 1
namespace pg8 {
#define PG8_LAS __attribute__((address_space(3)))
typedef unsigned short bf16_t;
typedef short bf16x8 __attribute__((ext_vector_type(8)));
typedef float f32x4 __attribute__((ext_vector_type(4)));
typedef unsigned u32x4 __attribute__((ext_vector_type(4)));
constexpr int BM = 256, BK = 64, HALF = 128, HTB = HALF * BK * 2  , STAGE_BYTES = 8 * HTB, NXCD = 8, WGM = 8;

__host__ __device__ __forceinline__ int lds_byte(int r, int c) { const int st = (r >> 4) * 2 + (c >> 5), rr = r & 15, cc = c & 31, ob = rr * 64 + cc * 2; return st * 1024 + (ob ^ (((ob >> 9) & 1) << 5)); }
__host__ __device__ __forceinline__ void stage_rc(int b, int& R, int& C) { const int st = b / 1024, sb = b % 1024, swz = sb ^ (((sb >> 9) & 1) << 5); R = (st >> 1) * 16 + swz / 64; C = (st & 1) * 32 + (swz % 64) / 2; }
__host__ __device__ __forceinline__ int perm32(int rho) { const int n = rho >> 4, i = rho & 15; return 8 * (i >> 2) + 4 * n + (i & 3); }

struct Unit { int pm, pn; };
struct Gemm { const bf16_t* A; const bf16_t* Bt; int M, N, K; };

struct StaticOrder {
    int nM, nN, nwg, G, c;
    __host__ __device__ void init(int M, int N, int G_, int c_) { nM = M / BM; nN = N / BM; nwg = nM * nN; G = G_; c = c_; }
    __host__ __device__ bool next(int i, Unit& u) const {
        const long L = (long)i * G + c; if (L >= nwg) return false;
        int wgid = (int)L; { const int q = nwg / NXCD, r = nwg % NXCD, xcd = wgid % NXCD, off = wgid / NXCD; wgid = (xcd < r ? xcd * (q + 1) : r * (q + 1) + (xcd - r) * q) + off; }
        const int nig = WGM * nN, gid = wgid / nig, fm = gid * WGM, gsz = (nM - fm) < WGM ? (nM - fm) : WGM;
        u.pm = fm + ((wgid % nig) % gsz); u.pn = (wgid % nig) / gsz; return true;
    }
    __device__ __forceinline__ void a_ready(const Unit&) const {}
    __device__ __forceinline__ void done(const Unit&) const {}
};


typedef float f32x2 __attribute__((ext_vector_type(2)));
typedef __bf16 bf16x2_t __attribute__((ext_vector_type(2)));
__device__ __forceinline__ unsigned cvt_pk_bf16(float lo, float hi) { f32x2 v = {lo, hi}; bf16x2_t b = __builtin_convertvector(v, bf16x2_t); return __builtin_bit_cast(unsigned, b); }

struct EpiBf16 {
    static constexpr bool PERM = true, AFTER_DRAIN = false;
    bf16_t* O; int ldc; int nvalid;
    __device__ __forceinline__ void operator()(const f32x4 (&acc)[2][2][4][2], const Unit& u, int wr, int wc, int fr, int fq) const {
        const int row0 = u.pm * BM + wr * 64 + fr; const int col0 = u.pn * BM + wc * 32 + 8 * fq;
#pragma unroll
        for (int ai = 0; ai < 2; ++ai)
#pragma unroll
            for (int m = 0; m < 4; ++m) { bf16_t* rowp = O + (size_t)(row0 + ai * HALF + m * 16) * ldc + col0;
#pragma unroll
                for (int bj = 0; bj < 2; ++bj) { if (col0 + bj * HALF < nvalid) { const f32x4 v0 = acc[ai][bj][m][0], v1 = acc[ai][bj][m][1];
                    u32x4 w; w.x = cvt_pk_bf16(v0[0], v0[1]); w.y = cvt_pk_bf16(v0[2], v0[3]); w.z = cvt_pk_bf16(v1[0], v1[1]); w.w = cvt_pk_bf16(v1[2], v1[3]);
                    __builtin_nontemporal_store(w, (u32x4*)(rowp + bj * HALF)); } } }
    }
};
struct EpiResF32 {
    static constexpr bool PERM = false, AFTER_DRAIN = false;
    const float* xp; const float* xs; float* out;
    __device__ __forceinline__ void operator()(const f32x4 (&acc)[2][2][4][2], const Unit& u, int wr, int wc, int fr, int fq) const {
        const int row0 = u.pm * BM + wr * 64 + fr; const int col0 = u.pn * BM + wc * 32 + 4 * fq;
        const float* xb = (u.pm * BM < 8192) ? xp : (xs - (size_t)8192 * 2048);
#pragma unroll
        for (int ai = 0; ai < 2; ++ai)
#pragma unroll
            for (int m = 0; m < 4; ++m) { const size_t off = (size_t)(row0 + ai * HALF + m * 16) * 2048 + col0;
#pragma unroll
                for (int bj = 0; bj < 2; ++bj)
#pragma unroll
                    for (int n = 0; n < 2; ++n) { const f32x4 xv = *(const f32x4*)(xb + off + bj * HALF + n * 16); *(f32x4*)(out + off + bj * HALF + n * 16) = xv + acc[ai][bj][m][n]; } }
    }
};
template <class Epi, class Sched, bool ALIGN_EPI = false, bool SP2 = false>
__device__ __forceinline__ void gemm_phase(PG8_LAS unsigned char* lds, const Gemm g, const Sched& S, const Epi& E) {
    const int tid = threadIdx.x, wid = __builtin_amdgcn_readfirstlane(tid >> 6), lane = tid & 63, wr = wid >> 2, wc = wid & 3, fr = lane & 15, fq = lane >> 4;
    const int K = g.K, nt = K / BK;
    unsigned voffA[2], voffB[2];
#pragma unroll
    for (int i = 0; i < 2; ++i) { int R, C; stage_rc(tid * 16 + i * 8192, R, C); const int Rb = Epi::PERM ? ((R & ~31) + perm32(R & 31)) : R;
        voffA[i] = (unsigned)(R * K + C) * 2u; voffB[i] = (unsigned)(Rb * K + C) * 2u; }
    const size_t kstep = (size_t)(BK * 2);
    const size_t hstep = (size_t)HALF * K * 2;
    const size_t tstep = 2 * hstep;
    const unsigned ldsw = (unsigned)wid * 1024u;
    const int aoff = lds_byte(wr * 64 + fr, fq * 8), boff = lds_byte(wc * 32 + fr, fq * 8);
#define PG8_SA(b, h) (((b) * 2 + (h)) * HTB)
#define PG8_SB(b, h) ((4 + (b) * 2 + (h)) * HTB)
#define PG8_STAGE(bufoff, gbase, voff) do { _Pragma("unroll") for (int _i = 0; _i < 2; ++_i) \
        __builtin_amdgcn_global_load_lds((const unsigned*)((const char*)(gbase) + (voff)[_i]), (PG8_LAS unsigned*)(lds + (bufoff) + ldsw + _i * 8192), 16, 0, 0); } while (0)
#define PG8_LDA(dst, b, h) do { _Pragma("unroll") for (int m = 0; m < 4; ++m) _Pragma("unroll") for (int k = 0; k < 2; ++k) dst[m][k] = *(const PG8_LAS bf16x8*)(lds + PG8_SA(b, h) + aoff + m * 2048 + k * 1024); } while (0)
#define PG8_LDB(dst, b, h) do { _Pragma("unroll") for (int n = 0; n < 2; ++n) _Pragma("unroll") for (int k = 0; k < 2; ++k) dst[n][k] = *(const PG8_LAS bf16x8*)(lds + PG8_SB(b, h) + boff + n * 2048 + k * 1024); } while (0)
#define PG8_MMA(ai, bj, At, Bt) do { __builtin_amdgcn_s_setprio(1); _Pragma("unroll") for (int m = 0; m < 4; ++m) _Pragma("unroll") for (int n = 0; n < 2; ++n) _Pragma("unroll") for (int k = 0; k < 2; ++k) \
        acc[ai][bj][m][n] = __builtin_amdgcn_mfma_f32_16x16x32_bf16(Bt[n][k], At[m][k], acc[ai][bj][m][n], 0, 0, 0); __builtin_amdgcn_s_setprio(0); } while (0)
#define PG8_WAIT_V(n) asm volatile("s_waitcnt vmcnt(" #n ")" ::: "memory")
#define PG8_WAIT_L(n) asm volatile("s_waitcnt lgkmcnt(" #n ")" ::: "memory")
#define PG8_BAR __builtin_amdgcn_s_barrier()
#define PG8_SCHED __builtin_amdgcn_sched_barrier(0)
    Unit cur, nxt; int ui = 0;
    if (!S.next(0, cur)) return;
    f32x4 acc[2][2][4][2];
#pragma unroll
    for (int a = 0; a < 2; ++a)
#pragma unroll
        for (int b = 0; b < 2; ++b)
#pragma unroll
            for (int m = 0; m < 4; ++m)
#pragma unroll
                for (int n = 0; n < 2; ++n) acc[a][b][m][n] = (f32x4){0.f, 0.f, 0.f, 0.f};
    bf16x8 At[4][2], B0[2][2], B1[2][2];
    const char* cA = (const char*)g.A + (size_t)cur.pm * tstep; const char* cB = (const char*)g.Bt + (size_t)cur.pn * tstep;
    S.a_ready(cur);
    if constexpr (SP2) {
        PG8_STAGE(PG8_SB(0, 0), cB, voffB); PG8_STAGE(PG8_SB(0, 1), cB + hstep, voffB); PG8_STAGE(PG8_SA(0, 0), cA, voffA); PG8_STAGE(PG8_SA(0, 1), cA + hstep, voffA);
        if (wr == 1) PG8_BAR;
        PG8_WAIT_V(2); PG8_BAR;
        PG8_STAGE(PG8_SB(1, 0), cB + kstep, voffB); PG8_STAGE(PG8_SA(1, 0), cA + kstep, voffA); PG8_STAGE(PG8_SB(1, 1), cB + hstep + kstep, voffB);
        PG8_WAIT_V(6); PG8_BAR;
    } else {
        PG8_STAGE(PG8_SB(0, 0), cB, voffB); PG8_STAGE(PG8_SA(0, 0), cA, voffA); PG8_STAGE(PG8_SB(0, 1), cB + hstep, voffB); PG8_STAGE(PG8_SA(0, 1), cA + hstep, voffA);
        if (wr == 1) PG8_BAR;
        PG8_WAIT_V(4); PG8_BAR;
        PG8_STAGE(PG8_SB(1, 0), cB + kstep, voffB); PG8_STAGE(PG8_SA(1, 0), cA + kstep, voffA); PG8_STAGE(PG8_SB(1, 1), cB + hstep + kstep, voffB);
        PG8_WAIT_V(6); PG8_BAR;
    }
    for (;;) {
        const bool has_next = S.next(ui + 1, nxt);
        const char* nA = has_next ? (const char*)g.A + (size_t)nxt.pm * tstep : cA; const char* nB = has_next ? (const char*)g.Bt + (size_t)nxt.pn * tstep : cB;
        for (int t = 0; t < nt; t += 2) {
            const bool last = (t == nt - 2);
            const char* a1 = cA + (size_t)(t + 1) * kstep;
            const char* a2 = last ? nA : cA + (size_t)(t + 2) * kstep; const char* b2 = last ? nB : cB + (size_t)(t + 2) * kstep;
            const char* a3 = a2 + kstep; const char* b3 = b2 + kstep;
            if (last && has_next) S.a_ready(nxt);
            if constexpr (SP2) {
            PG8_LDB(B0, 0, 0); PG8_LDB(B1, 0, 1); PG8_SCHED; PG8_LDA(At, 0, 0); PG8_STAGE(PG8_SA(1, 1), a1 + hstep, voffA);
            PG8_WAIT_V(8); PG8_WAIT_L(0); PG8_BAR; PG8_MMA(0, 0, At, B0); PG8_MMA(0, 1, At, B1); PG8_BAR; PG8_SCHED;
            PG8_LDA(At, 0, 1); PG8_STAGE(PG8_SB(0, 0), b2, voffB); PG8_STAGE(PG8_SB(0, 1), b2 + hstep, voffB); PG8_STAGE(PG8_SA(0, 0), a2, voffA);
            PG8_WAIT_V(8); PG8_WAIT_L(0); PG8_BAR; PG8_MMA(1, 0, At, B0); PG8_MMA(1, 1, At, B1); PG8_BAR; PG8_SCHED;
            PG8_LDB(B0, 1, 0); PG8_LDB(B1, 1, 1); PG8_SCHED; PG8_LDA(At, 1, 0); PG8_STAGE(PG8_SA(0, 1), a2 + hstep, voffA);
            PG8_WAIT_V(8); PG8_WAIT_L(0); PG8_BAR; PG8_MMA(0, 0, At, B0); PG8_MMA(0, 1, At, B1); PG8_BAR; PG8_SCHED;
            PG8_LDA(At, 1, 1); PG8_STAGE(PG8_SB(1, 0), b3, voffB); PG8_STAGE(PG8_SB(1, 1), b3 + hstep, voffB); PG8_STAGE(PG8_SA(1, 0), a3, voffA);
            PG8_WAIT_V(8); PG8_WAIT_L(0); PG8_BAR; PG8_MMA(1, 0, At, B0); PG8_MMA(1, 1, At, B1); PG8_BAR; PG8_SCHED;
            } else {
            PG8_LDB(B0, 0, 0); PG8_SCHED; PG8_LDA(At, 0, 0); PG8_STAGE(PG8_SA(1, 1), a1 + hstep, voffA);
            PG8_WAIT_L(8); PG8_BAR; PG8_WAIT_L(0); PG8_MMA(0, 0, At, B0); PG8_BAR; PG8_SCHED;
            PG8_LDB(B1, 0, 1); PG8_STAGE(PG8_SB(0, 0), b2, voffB);
            PG8_BAR; PG8_WAIT_L(0); PG8_MMA(0, 1, At, B1); PG8_BAR;
            PG8_LDA(At, 0, 1); PG8_STAGE(PG8_SA(0, 0), a2, voffA);
            PG8_BAR; PG8_WAIT_L(0); PG8_MMA(1, 0, At, B0); PG8_BAR; PG8_SCHED;
            PG8_STAGE(PG8_SB(0, 1), b2 + hstep, voffB);
            PG8_WAIT_V(6); PG8_BAR; PG8_MMA(1, 1, At, B1); PG8_BAR;
            PG8_LDB(B0, 1, 0); PG8_SCHED; PG8_LDA(At, 1, 0); PG8_STAGE(PG8_SA(0, 1), a2 + hstep, voffA);
            PG8_WAIT_L(8); PG8_BAR; PG8_WAIT_L(0); PG8_MMA(0, 0, At, B0); PG8_BAR; PG8_SCHED;
            PG8_LDB(B1, 1, 1); PG8_STAGE(PG8_SB(1, 0), b3, voffB);
            PG8_BAR; PG8_WAIT_L(0); PG8_MMA(0, 1, At, B1); PG8_BAR;
            PG8_LDA(At, 1, 1); PG8_STAGE(PG8_SA(1, 0), a3, voffA);
            PG8_BAR; PG8_WAIT_L(0); PG8_MMA(1, 0, At, B0); PG8_BAR; PG8_SCHED;
            PG8_STAGE(PG8_SB(1, 1), b3 + hstep, voffB);
            PG8_WAIT_V(6); PG8_BAR; PG8_MMA(1, 1, At, B1); PG8_BAR;
            }
        }
        if constexpr (ALIGN_EPI) { if (wr == 0) PG8_BAR; }
        if constexpr (!Epi::AFTER_DRAIN) { E(acc, cur, wr, wc, fr, fq); S.done(cur); }
        if (!has_next) break;
#pragma unroll
        for (int a = 0; a < 2; ++a)
#pragma unroll
            for (int b = 0; b < 2; ++b)
#pragma unroll
                for (int m = 0; m < 4; ++m)
#pragma unroll
                    for (int n = 0; n < 2; ++n) acc[a][b][m][n] = (f32x4){0.f, 0.f, 0.f, 0.f};
        cur = nxt; cA = nA; cB = nB; ++ui;
        if constexpr (ALIGN_EPI) { if (wr == 1) PG8_BAR; }
    }
    PG8_WAIT_V(0);
    if constexpr (!ALIGN_EPI) { if (wr == 0) PG8_BAR; }
    PG8_BAR;
    if constexpr (Epi::AFTER_DRAIN) { E.fused(acc, cur, wr, wc, fr, fq, lds, wid, lane); S.done(cur); }
#undef PG8_SA
#undef PG8_SB
#undef PG8_STAGE
#undef PG8_LDA
#undef PG8_LDB
#undef PG8_MMA
#undef PG8_WAIT_V
#undef PG8_WAIT_L
#undef PG8_BAR
#undef PG8_SCHED
}
}

#ifndef MK_N_LAUNCHES
#define MK_N_LAUNCHES 1
#endif
constexpr int NWAVES = 8, NTHREADS = 512;
constexpr int DM = 2048, MTOK = 24576, DIN = 8320, DINP = 8448;
constexpr int C_K = 1024, C_V = 2048, C_WD = 3072, C_AD = 3136, C_GR = 3200, C_QD = 4224, C_KD = 5248, C_VD = 6272, C_GD = 7296;
constexpr size_t MiB = 1u << 20;
constexpr size_t WS_CTL = 0, WS_WOUT = 1 * MiB, WS_PROJ = 10 * MiB, WS_CONCAT = 400 * MiB, WS_WIN = 400 * MiB, WS_END = 496 * MiB, WS_TOTAL = 512 * MiB;
constexpr size_t DO_OF = 48 * MiB, DO_OB = 96 * MiB;
constexpr int LDS_BYTES = 147456;
constexpr float QSCALE = 0.18033688011112042f;

#define LAS __attribute__((address_space(3)))
typedef unsigned short bf16;
typedef unsigned v4u __attribute__((ext_vector_type(4)));
typedef unsigned v2u __attribute__((ext_vector_type(2)));
typedef float f32x4 __attribute__((ext_vector_type(4)));
typedef float f32x16 __attribute__((ext_vector_type(16)));
typedef short bf16x8 __attribute__((ext_vector_type(8)));
typedef short s16x4 __attribute__((ext_vector_type(4)));

__device__ __forceinline__ float bf2f(bf16 v) { return __uint_as_float(((unsigned)v) << 16); }
__device__ __forceinline__ float bflo(unsigned w) { return __uint_as_float(w << 16); }
__device__ __forceinline__ float bfhi(unsigned w) { return __uint_as_float(w & 0xffff0000u); }
__device__ __forceinline__ unsigned pk2(float lo, float hi) { return pg8::cvt_pk_bf16(lo, hi); }
__device__ __forceinline__ bf16 f2bf(float f) { return (bf16)(pk2(f, 0.f) & 0xffffu); }
__device__ __forceinline__ float wave_sum(float v) {
#pragma unroll
    for (int o = 1; o < 64; o <<= 1) v += __shfl_xor(v, o);
    return v;
}
__device__ __forceinline__ float wave_max(float v) {
#pragma unroll
    for (int o = 1; o < 64; o <<= 1) v = fmaxf(v, __shfl_xor(v, o));
    return v;
}
__device__ __forceinline__ float sigmoid_f(float x) { return 1.0f / (1.0f + __expf(-x)); }

__device__ __forceinline__ f32x4 unpk4(v2u w) { return (f32x4){bflo(w.x), bfhi(w.x), bflo(w.y), bfhi(w.y)}; }
__device__ __forceinline__ float sum4(f32x4 v) { return (v.x + v.y) + (v.z + v.w); }
struct Args { const float* in[19]; float* out; unsigned char* ws; int ph_lo, ph_hi; };

__device__ __forceinline__ void p0_transpose_item(const float* W, int K, int N, bf16* WT, LAS float* scr, int item, int lane) {
    const int nblk = N / 32, kb = item / nblk, nb = item % nblk, k0 = 64 * kb, n0 = 32 * nb;
#pragma unroll 8
    for (int i = 0; i < 32; ++i) { const int kk = 2 * i + (lane >> 5); scr[kk * 33 + (lane & 31)] = W[(size_t)(k0 + kk) * N + n0 + (lane & 31)]; }
    asm volatile("s_waitcnt lgkmcnt(0)" ::: "memory");
    const int c = lane & 7;
#pragma unroll
    for (int j = 0; j < 4; ++j) { const int n = (lane >> 3) + 8 * j; const LAS float* s = scr + (8 * c) * 33 + n;
        v4u o; o.x = pk2(s[0 * 33], s[1 * 33]); o.y = pk2(s[2 * 33], s[3 * 33]); o.z = pk2(s[4 * 33], s[5 * 33]); o.w = pk2(s[6 * 33], s[7 * 33]);
        *(v4u*)(WT + (size_t)(n0 + n) * K + k0 + 8 * c) = o; }
    asm volatile("s_waitcnt lgkmcnt(0)" ::: "memory");
}
__device__ __forceinline__ void rms_row_to_bf16(const float* xrow, const float* gain, bf16* orow, int lane) {
    const f32x4* xr = (const f32x4*)xrow + lane; const f32x4* gr = (const f32x4*)gain + lane;
    f32x4 v[8]; float s = 0.f;
#pragma unroll
    for (int j = 0; j < 8; ++j) { v[j] = xr[64 * j]; s += (v[j].x * v[j].x + v[j].y * v[j].y) + (v[j].z * v[j].z + v[j].w * v[j].w); }
    const float rstd = rsqrtf(wave_sum(s) * (1.f / DM) + 1e-6f);
    unsigned long long* o8 = (unsigned long long*)orow + lane;
#pragma unroll
    for (int j = 0; j < 8; ++j) { const f32x4 g = gr[64 * j];
        o8[64 * j] = (unsigned long long)pk2(v[j].x * rstd * g.x, v[j].y * rstd * g.y) | ((unsigned long long)pk2(v[j].z * rstd * g.z, v[j].w * rstd * g.w) << 32); }
}
__device__ __forceinline__ void p0_prologue(const Args& a, LAS unsigned char* lds, int tid, int wave, int lane) {
    LAS float* scr = (LAS float*)(lds + wave * 16384);
    const int gw = blockIdx.x * NWAVES + wave, NGW = gridDim.x * NWAVES;
    bf16* Win_t = (bf16*)(a.ws + WS_WIN); bf16* Wout_t = (bf16*)(a.ws + WS_WOUT); bf16* XN = (bf16*)a.out;
    constexpr int I_IN = (DM / 64) * (DIN / 32), I_OUT = (DM / 64) * (DM / 32);
    for (int it = gw; it < I_IN + I_OUT; it += NGW) {
        if (it < I_IN) p0_transpose_item(a.in[3], DM, DIN, Win_t, scr, it, lane);
        else p0_transpose_item(a.in[18], DM, DM, Wout_t, scr, it - I_IN, lane);
    }
    { v4u* z = (v4u*)(Win_t + (size_t)DIN * DM); const v4u zero = {0u, 0u, 0u, 0u};
      for (int i = blockIdx.x * NTHREADS + tid; i < (DINP - DIN) * DM * 2 / 16; i += gridDim.x * NTHREADS) z[i] = zero; }
    for (int m = gw; m < MTOK; m += NGW) {
        const float* xrow = m < 8192 ? a.in[0] + (size_t)m * DM : a.in[1] + (size_t)(m - 8192) * DM;
        rms_row_to_bf16(xrow, a.in[2], XN + (size_t)m * DM, lane);
    }
}

__device__ __forceinline__ float dpp_sum16(float v) {
    v += __builtin_bit_cast(float, __builtin_amdgcn_update_dpp(0, __builtin_bit_cast(int, v), 0xB1, 0xf, 0xf, true));
    v += __builtin_bit_cast(float, __builtin_amdgcn_update_dpp(0, __builtin_bit_cast(int, v), 0x4E, 0xf, 0xf, true));
    v += __builtin_bit_cast(float, __builtin_amdgcn_update_dpp(0, __builtin_bit_cast(int, v), 0x141, 0xf, 0xf, true));
    v += __builtin_bit_cast(float, __builtin_amdgcn_update_dpp(0, __builtin_bit_cast(int, v), 0x140, 0xf, 0xf, true));
    return v;
}
__device__ __forceinline__ float dpp_xor2(float v) { return __builtin_bit_cast(float, __builtin_amdgcn_update_dpp(0, __builtin_bit_cast(int, v), 0x4E, 0xf, 0xf, true)); }
__device__ __forceinline__ void attn_prep(const Args& a, LAS unsigned char* lds, int wave, int lane) {
    bf16* PROJ = (bf16*)(a.ws + WS_PROJ); bf16* VT = (bf16*)a.out;
    const int vec = lane >> 4, c16 = lane & 15;
    const f32x4 gain4 = *(const f32x4*)((vec < 2 ? a.in[14] : a.in[15]) + c16 * 4);
    const float oscale = vec < 2 ? QSCALE : 1.f;
    const int vcol = (vec < 2 ? C_QD : C_KD) + (vec & 1) * 64 + c16 * 4;
    f32x4 invf4;
#pragma unroll
    for (int j = 0; j < 4; ++j) invf4[j] = exp2f(-(float)((c16 & 1) * 4 + j) * 2.3664460711655218f) * 0.15915494309189535f;
    const float sgn = (c16 & 2) ? 1.f : -1.f;
    LAS unsigned char* tile = lds + wave * 16640;
    const int gw = blockIdx.x * NWAVES + wave, NGW = gridDim.x * NWAVES;
    for (int item = gw; item < 8 * 384; item += NGW) {
        const int hd = item / 384, gblk = item % 384, mb = gblk * 64;
        const int tpos0 = mb < 8192 ? mb : ((mb - 8192) & 2047);
#pragma unroll 2
        for (int tok = 0; tok < 64; ++tok) {
            bf16* p = PROJ + (size_t)(mb + tok) * DIN + hd * 128 + vcol;
            f32x4 x = unpk4(*(const v2u*)p);
            const float ss = dpp_sum16((x.x * x.x + x.y * x.y) + (x.z * x.z + x.w * x.w));
            x = x * (rsqrtf(ss * (1.f / 64) + 1e-6f) * oscale) * gain4;
            const float tf = (float)(tpos0 + tok);
            f32x4 xr;
#pragma unroll
            for (int j = 0; j < 4; ++j) { float rev = tf * invf4[j]; rev -= floorf(rev);
                const float cs = __builtin_amdgcn_cosf(rev), sn = __builtin_amdgcn_sinf(rev) * sgn;
                xr[j] = x[j] * cs + dpp_xor2(x[j]) * sn; }
            if (c16 < 4) x = xr;
            v2u w; w.x = pk2(x.x, x.y); w.y = pk2(x.z, x.w);
            *(v2u*)p = w;
        }
#pragma unroll 4
        for (int it = 0; it < 16; ++it) { const int id = it * 64 + lane, r = id >> 4, ch = id & 15;
            const v4u val = *(const v4u*)(PROJ + (size_t)(mb + r) * DIN + C_VD + hd * 128 + ch * 8);
            LAS unsigned* dst = (LAS unsigned*)(tile + r * 260 + ch * 16); dst[0] = val.x; dst[1] = val.y; dst[2] = val.z; dst[3] = val.w; }
        asm volatile("s_waitcnt lgkmcnt(0)" ::: "memory");
#pragma unroll 8
        for (int d = 0; d < 128; ++d) { const bf16 v = *(const LAS bf16*)(tile + lane * 260 + d * 2); VT[(size_t)(hd * 128 + d) * MTOK + mb + lane] = v; }
        asm volatile("s_waitcnt lgkmcnt(0)" ::: "memory");
    }
}

constexpr int TC = 32, ZSTR = 784;
constexpr int LB_KK = 0, LB_WW = LB_KK + TC * 256, LB_BB = LB_WW + TC * 256, LB_KD = LB_BB + TC * 256, LB_RR = LB_KD + TC * 256, LB_VV = LB_RR + TC * 256, LB_OUT = LB_VV + TC * 256,
              LB_ZS = LB_OUT + TC * 256  , LB_RAW = LB_ZS + TC * ZSTR, LB_MU = LB_RAW + (TC + 2) * 640, LB_END = LB_MU + 1280;
static_assert(LB_END <= LDS_BYTES - 64, "scan LDS");
typedef float f32x2v __attribute__((ext_vector_type(2)));
template <int LPR> __device__ __forceinline__ float dpp_sum_row(float v) {
    v += __builtin_bit_cast(float, __builtin_amdgcn_update_dpp(0, __builtin_bit_cast(int, v), 0xB1, 0xf, 0xf, true));
    v += __builtin_bit_cast(float, __builtin_amdgcn_update_dpp(0, __builtin_bit_cast(int, v), 0x4E, 0xf, 0xf, true));
    v += __builtin_bit_cast(float, __builtin_amdgcn_update_dpp(0, __builtin_bit_cast(int, v), 0x141, 0xf, 0xf, true));
    if (LPR == 16) v += __builtin_bit_cast(float, __builtin_amdgcn_update_dpp(0, __builtin_bit_cast(int, v), 0x140, 0xf, 0xf, true));
    return v;
}
__device__ __forceinline__ float fast_sigmoid(float x) { return __builtin_amdgcn_rcpf(1.0f + __expf(-x)); }
#define LDS_BARRIER() asm volatile("s_waitcnt lgkmcnt(0)\n\ts_barrier" ::: "memory")
template <int DIR, int RPW>
__device__ __forceinline__ void scan_unit(const Args& a, LAS unsigned char* lds, int seq, int h, int half, int tid_in) {
    constexpr int LPR = 64 / RPW, KS = RPW, NP = KS / 2, OSTR = 8 * RPW;
    int tid = tid_in; asm volatile("" : "+v"(tid));
    const int lane = tid & 63, wave = __builtin_amdgcn_readfirstlane(tid >> 6);
    const bf16* PROJ = (const bf16*)(a.ws + WS_PROJ);
    bf16* OD = (bf16*)((unsigned char*)a.out + (DIR ? DO_OB : DO_OF));
    const int m0 = seq == 0 ? 0 : 8192 + (seq - 1) * 2048, T = seq == 0 ? 8192 : 2048, nch = T / TC;
    const int rbase = RPW == 4 ? half * 32 : 0;
    const int sb_t = tid >> 4, c16 = tid & 15;
    if (tid < 320) { const int g = tid >> 6, c = tid & 63; const int gc = g < 3 ? g * 1024 + h * 64 + c : (g == 3 ? C_WD + c : C_AD + c); ((LAS float*)(lds + LB_MU))[tid] = a.in[4][gc]; }
    const f32x4 kk4c = *(const f32x4*)(a.in[9] + h * 64 + c16 * 4);
    const int mat = wave >> 2, nt4 = wave & 3, quad = lane >> 4, l15 = lane & 15, ncol = h * 64 + nt4 * 16 + l15;
    const float c0v = (mat == 0 ? a.in[5] : a.in[7])[DIR * 1024 + ncol], kav = a.in[10][ncol];
    bf16x8 bfr[2];
    { const float* UP = (mat == 0 ? a.in[6] : a.in[8]) + (size_t)DIR * 64 * 1024 + ncol;
#pragma unroll
      for (int ks = 0; ks < 2; ++ks) { float x[8];
#pragma unroll
          for (int j = 0; j < 8; ++j) x[j] = UP[(size_t)(ks * 32 + quad * 8 + j) * 1024];
          v4u p; p.x = pk2(x[0], x[1]); p.y = pk2(x[2], x[3]); p.z = pk2(x[4], x[5]); p.w = pk2(x[6], x[7]); bfr[ks] = __builtin_bit_cast(bf16x8, p); } }
    int crr[3], ccol[3], coff[3]; bool cval[3];
#pragma unroll
    for (int i = 0; i < 3; ++i) { const int ch = tid + 512 * i; cval[i] = ch < (TC + 2) * 40; const int rr = ch / 40, rem = ch % 40, g = rem >> 3, c8 = rem & 7;
        crr[i] = rr; ccol[i] = (g < 3 ? g * 1024 + h * 64 : (g == 3 ? C_WD : C_AD)) + c8 * 8; coff[i] = LB_RAW + rr * 640 + (g * 64 + c8 * 8) * 2; }
    f32x2v S[NP];
#pragma unroll
    for (int j = 0; j < NP; ++j) S[j] = (f32x2v){0.f, 0.f};
    const int rowl = lane / LPR, kq = lane % LPR, vrow = rbase + wave * RPW + rowl;
    const LAS unsigned char* opb = lds + kq * (KS * 4);
    const LAS unsigned char* vvb = lds + LB_VV + vrow * 4;
    LAS float* outp = (LAS float*)(lds + LB_OUT) + wave * RPW + rowl;
    v4u pre[3];
#define SCAN_LOAD(cc) do { const int t0_ = (DIR ? nch - 1 - (cc) : (cc)) * TC; _Pragma("unroll") for (int i = 0; i < 3; ++i) { const int t_ = t0_ - 1 + crr[i]; \
        const bool ok_ = cval[i] && t_ >= 0 && t_ < T; v4u z_ = {0u, 0u, 0u, 0u}; if (ok_) z_ = *(const v4u*)(PROJ + (size_t)(m0 + t_) * DIN + ccol[i]); pre[i] = z_; } } while (0)
    SCAN_LOAD(0);
#pragma unroll
    for (int i = 0; i < 3; ++i) if (cval[i]) *(LAS v4u*)(lds + coff[i]) = pre[i];
    LDS_BARRIER();
    if (nch > 1) SCAN_LOAD(1);
#pragma nounroll
    for (int c = 0; c < nch; ++c) {
        const int t0 = (DIR ? nch - 1 - c : c) * TC;
#pragma unroll
        for (int g = 0; g < 5; ++g) {
            const LAS unsigned char* rp = lds + LB_RAW + sb_t * 640 + (g * 64 + c16 * 4) * 2;
            const v2u wp = *(const LAS v2u*)rp, wz = *(const LAS v2u*)(rp + 640), wn = *(const LAS v2u*)(rp + 1280);
            const f32x4 mu4 = *(const LAS f32x4*)(lds + LB_MU + (g * 64 + c16 * 4) * 4);
            const f32x4 z = {bflo(wz.x), bfhi(wz.x), bflo(wz.y), bfhi(wz.y)}, zp = {bflo(wp.x), bfhi(wp.x), bflo(wp.y), bfhi(wp.y)}, zn = {bflo(wn.x), bfhi(wn.x), bflo(wn.y), bfhi(wn.y)};
            f32x4 zs = z + mu4 * (0.5f * (zp + zn) - z);
            if (g == 3) {
#pragma unroll
                for (int j = 0; j < 4; ++j) zs[j] = 1.f - 2.f * __builtin_amdgcn_rcpf(__expf(2.f * zs[j]) + 1.f); }
            *(LAS f32x4*)(lds + (g == 0 ? LB_RR + sb_t * 256 : g == 2 ? LB_VV + sb_t * 256 : LB_ZS + sb_t * ZSTR + (g == 1 ? 0 : g == 3 ? 256 : 512)) + c16 * 16) = zs;
            if (g == 1) { const f32x4 kr = zs * kk4c; const float ss = dpp_sum_row<16>((kr.x * kr.x + kr.y * kr.y) + (kr.z * kr.z + kr.w * kr.w));
                *(LAS f32x4*)(lds + LB_KK + sb_t * 256 + c16 * 16) = kr * rsqrtf(fmaxf(ss, 1e-12f)); }
        }
        LDS_BARRIER();
#pragma unroll
        for (int mt = 0; mt < 2; ++mt) { f32x4 acc = {0.f, 0.f, 0.f, 0.f};
#pragma unroll
            for (int ks = 0; ks < 2; ++ks) { const LAS unsigned char* ap = lds + LB_ZS + (mt * 16 + l15) * ZSTR + (64 + mat * 64 + ks * 32 + quad * 8) * 4;
                const f32x4 x0 = *(const LAS f32x4*)ap, x1 = *(const LAS f32x4*)(ap + 16);
                v4u p; p.x = pk2(x0.x, x0.y); p.y = pk2(x0.z, x0.w); p.z = pk2(x1.x, x1.y); p.w = pk2(x1.z, x1.w);
                acc = __builtin_amdgcn_mfma_f32_16x16x32_bf16(__builtin_bit_cast(bf16x8, p), bfr[ks], acc, 0, 0, 0); }
#pragma unroll
            for (int j = 0; j < 4; ++j) { const int t = mt * 16 + quad * 4 + j, n = nt4 * 16 + l15; const float sg = fast_sigmoid(acc[j] + c0v);
                if (mat == 0) *(LAS float*)(lds + LB_WW + t * 256 + n * 4) = __expf(-0.606531f * sg);
                else { const float kv = *(const LAS float*)(lds + LB_ZS + t * ZSTR + n * 4);
                    *(LAS float*)(lds + LB_KD + t * 256 + n * 4) = kv * (1.f + (sg - 1.f) * kav); *(LAS float*)(lds + LB_BB + t * 256 + n * 4) = sg * *(const LAS float*)(lds + LB_KK + t * 256 + n * 4); } } }
        LDS_BARRIER();
        {
#define SC_LD(tt, KK2, W2, B2, KD2, R2, VV) do { _Pragma("unroll") for (int q_ = 0; q_ < NP; ++q_) { KK2[q_] = *(const LAS f32x2v*)(gb + LB_KK + (tt) * 256 + q_ * 8); W2[q_] = *(const LAS f32x2v*)(gb + LB_WW + (tt) * 256 + q_ * 8); \
            B2[q_] = *(const LAS f32x2v*)(gb + LB_BB + (tt) * 256 + q_ * 8); KD2[q_] = *(const LAS f32x2v*)(gb + LB_KD + (tt) * 256 + q_ * 8); R2[q_] = *(const LAS f32x2v*)(gb + LB_RR + (tt) * 256 + q_ * 8); } VV = *(const LAS float*)(gv + (tt) * 256); } while (0)
            f32x2v kk2[NP], w2[NP], b2[NP], kd2[NP], r2[NP]; float vv;
            { const int tf = DIR ? TC - 1 : 0; const LAS unsigned char* gb = opb + tf * 256; const LAS unsigned char* gv = vvb + tf * 256; SC_LD(0, kk2, w2, b2, kd2, r2, vv); }
#pragma nounroll
            for (int so = 0; so < 4; ++so) {
                constexpr int bias = DIR ? 1 : 0;
                const int tbase = (DIR ? TC - 8 - 8 * so : 8 * so) - bias;
                const LAS unsigned char* gb = opb + tbase * 256; const LAS unsigned char* gv = vvb + tbase * 256;
                LAS float* go = outp + tbase * OSTR;
#pragma unroll
                for (int j = 0; j < 8; ++j) { const int tj = (DIR ? 7 - j : j) + bias, tn = DIR ? tj - 1 : tj + 1;
                    f32x2v nkk2[NP], nw2[NP], nb2[NP], nkd2[NP], nr2[NP]; float nvv = vv;
#pragma unroll
                    for (int q = 0; q < NP; ++q) { nkk2[q] = kk2[q]; nw2[q] = w2[q]; nb2[q] = b2[q]; nkd2[q] = kd2[q]; nr2[q] = r2[q]; }
                    if (j < 7 || so < 3) SC_LD(tn, nkk2, nw2, nb2, nkd2, nr2, nvv);
                    f32x2v acc = S[0] * kk2[0];
#pragma unroll
                    for (int q = 1; q < NP; ++q) acc = S[q] * kk2[q] + acc;
                    const float sa = -dpp_sum_row<LPR>(acc.x + acc.y);
                    const f32x2v sa2 = {sa, sa}, vv2 = {vv, vv};
#pragma unroll
                    for (int q = 0; q < NP; ++q) S[q] = S[q] * w2[q] + (vv2 * kd2[q] + sa2 * b2[q]);
                    f32x2v oc = S[0] * r2[0];
#pragma unroll
                    for (int q = 1; q < NP; ++q) oc = S[q] * r2[q] + oc;
                    go[tj * OSTR] = dpp_sum_row<LPR>(oc.x + oc.y);
                    vv = nvv;
#pragma unroll
                    for (int q = 0; q < NP; ++q) { kk2[q] = nkk2[q]; w2[q] = nw2[q]; b2[q] = nb2[q]; kd2[q] = nkd2[q]; r2[q] = nr2[q]; }
                }
            }
#undef SC_LD
        }
        if (c + 1 < nch) {
#pragma unroll
            for (int i = 0; i < 3; ++i) if (cval[i]) *(LAS v4u*)(lds + coff[i]) = pre[i]; }
        LDS_BARRIER();
        if (c + 2 < nch) SCAN_LOAD(c + 2);
        if (tid < TC * RPW) { const int t = tid / RPW, q8 = tid % RPW; const LAS float* o = (const LAS float*)(lds + LB_OUT) + t * OSTR + q8 * 8;
            v4u w; w.x = pk2(o[0], o[1]); w.y = pk2(o[2], o[3]); w.z = pk2(o[4], o[5]); w.w = pk2(o[6], o[7]);
            *(v4u*)(OD + (size_t)(m0 + t0 + t) * 1024 + h * 64 + rbase + q8 * 8) = w; }
    }
#undef SCAN_LOAD
}

constexpr int QSTR = 272, KSTR = 144, VSTR = 136;
constexpr int A_QOFF = 0, A_KOFF = 256 * QSTR, A_KBUF = 64 * KSTR, A_VOFF = A_KOFF + 2 * A_KBUF, A_VBUF = 128 * VSTR, A_END = A_VOFF + 2 * A_VBUF;
static_assert(A_END <= LDS_BYTES - 64, "attention LDS");
#define MFMA32(a_, b_, c_) __builtin_amdgcn_mfma_f32_32x32x16_bf16((a_), (b_), (c_), 0, 0, 0)
__device__ __forceinline__ bf16x8 pack8(const f32x16& p, int b) {
    v4u w; w.x = pk2(p[b], p[b + 1]); w.y = pk2(p[b + 2], p[b + 3]); w.z = pk2(p[b + 4], p[b + 5]); w.w = pk2(p[b + 6], p[b + 7]); return __builtin_bit_cast(bf16x8, w);
}
__device__ __forceinline__ void attn_qk(f32x16& p0, f32x16& p1, const LAS unsigned char* qrow, const LAS unsigned char* Kb, const f32x16& negm) {
#pragma unroll
    for (int s = 0; s < 4; ++s) {
        const bf16x8 qf = *(const LAS bf16x8*)(qrow + s * 32);
        const bf16x8 a0 = *(const LAS bf16x8*)(Kb + s * 32), a1 = *(const LAS bf16x8*)(Kb + 32 * KSTR + s * 32);
        if (s == 0) { p0 = MFMA32(a0, qf, negm); p1 = MFMA32(a1, qf, negm); }
        else { p0 = MFMA32(a0, qf, p0); p1 = MFMA32(a1, qf, p1); }
    }
}
__device__ __forceinline__ void attn_exp(f32x16& p0, f32x16& p1, float M2, float& lsum, bf16x8 (&pf)[4]) {
    float ls = 0.f;
#pragma unroll
    for (int r = 0; r < 16; ++r) { p0[r] = __builtin_amdgcn_exp2f(p0[r]); p1[r] = __builtin_amdgcn_exp2f(p1[r]); ls += p0[r] + p1[r]; }
    lsum += ls;
    pf[0] = pack8(p0, 0); pf[1] = pack8(p0, 8); pf[2] = pack8(p1, 0); pf[3] = pack8(p1, 8);
}
__device__ __forceinline__ void attn_pv(f32x16 (&o)[4], const LAS unsigned char* Vb, const bf16x8 (&pf)[4]) {
    s16x4 lo[4], hi[4];
#pragma unroll
    for (int s2 = 0; s2 < 4; ++s2) { lo[s2] = *(const LAS s16x4*)(Vb + s2 * 32); hi[s2] = *(const LAS s16x4*)(Vb + s2 * 32 + 16); }
#pragma unroll
    for (int db = 0; db < 4; ++db) {
        s16x4 nlo[4], nhi[4];
#pragma unroll
        for (int s2 = 0; s2 < 4; ++s2) { nlo[s2] = lo[s2]; nhi[s2] = hi[s2]; }
        if (db < 3) {
#pragma unroll
            for (int s2 = 0; s2 < 4; ++s2) { nlo[s2] = *(const LAS s16x4*)(Vb + (db + 1) * 32 * VSTR + s2 * 32); nhi[s2] = *(const LAS s16x4*)(Vb + (db + 1) * 32 * VSTR + s2 * 32 + 16); } }
        __builtin_amdgcn_sched_barrier(0);
#pragma unroll
        for (int s2 = 0; s2 < 4; ++s2) o[db] = MFMA32(__builtin_shufflevector(lo[s2], hi[s2], 0, 1, 2, 3, 4, 5, 6, 7), pf[s2], o[db]);
        __builtin_amdgcn_sched_barrier(0);
#pragma unroll
        for (int s2 = 0; s2 < 4; ++s2) { lo[s2] = nlo[s2]; hi[s2] = nhi[s2]; }
    }
}
__device__ __forceinline__ void attn_unit(const Args& a, LAS unsigned char* lds, int seq, int hd, int qblk, int tid_in, float M2, float lam) {
    int tid = tid_in; asm volatile("" : "+v"(tid));
    const int lane = tid & 63, wave = __builtin_amdgcn_readfirstlane(tid >> 6);
    const bf16* PROJ = (const bf16*)(a.ws + WS_PROJ); const bf16* VT = (const bf16*)a.out; bf16* CONCAT = (bf16*)(a.ws + WS_CONCAT);
    const int m0 = seq == 0 ? 0 : 8192 + (seq - 1) * 2048, T = seq == 0 ? 8192 : 2048, nkt = T / 64;
    const int i = lane & 31, hh = lane >> 5;
    const int mq0 = m0 + qblk * 256 + wave * 32;
#pragma unroll
    for (int it = 0; it < 8; ++it) { const int id = it * 64 + lane, r = id >> 4, ch = id & 15;
        const v4u v = *(const v4u*)(PROJ + (size_t)(mq0 + r) * DIN + C_QD + hd * 128 + ch * 8);
        *(LAS v4u*)(lds + A_QOFF + (wave * 32 + r) * QSTR + ch * 16) = v; }
    const bf16* vsrc[2]; int vdst[2];
#pragma unroll
    for (int j = 0; j < 2; ++j) { const int id = tid + 512 * j, d = id >> 3, ch = id & 7; vsrc[j] = VT + (size_t)(hd * 128 + d) * MTOK + m0 + ch * 8; vdst[j] = A_VOFF + d * VSTR + ch * 16; }
    const int kdst = A_KOFF + (tid >> 3) * KSTR + (tid & 7) * 16;
    const int qoff = A_QOFF + (wave * 32 + i) * QSTR + hh * 16;
    f32x16 negm;
#pragma unroll
    for (int r = 0; r < 16; ++r) negm[r] = -M2;
    asm volatile("" : "+v"(negm));
    v4u* const stash = (v4u*)(a.ws + WS_END) + ((size_t)blockIdx.x * NTHREADS + tid_in) * 8;
#pragma nounroll
    for (int c = 0; c < 2; ++c) {
        const bf16* ksrc = PROJ + (size_t)(m0 + (tid >> 3)) * DIN + C_KD + hd * 128 + c * 64 + (tid & 7) * 8;
        v4u kreg, vreg[2];
        kreg = *(const v4u*)ksrc;
#pragma unroll
        for (int j = 0; j < 2; ++j) vreg[j] = *(const v4u*)vsrc[j];
        *(LAS v4u*)(lds + kdst) = kreg;
#pragma unroll
        for (int j = 0; j < 2; ++j) { *(LAS v2u*)(lds + vdst[j]) = (v2u){vreg[j].x, vreg[j].y}; *(LAS v2u*)(lds + vdst[j] + 8) = (v2u){vreg[j].z, vreg[j].w}; }
        kreg = *(const v4u*)(ksrc + (size_t)64 * DIN);
        *(LAS v4u*)(lds + kdst + A_KBUF) = kreg;
        LDS_BARRIER();
        f32x16 o[4];
#pragma unroll
        for (int db = 0; db < 4; ++db)
#pragma unroll
            for (int r = 0; r < 16; ++r) o[db][r] = 0.f;
        float lsum = 0.f;
        f32x16 pn0, pn1;
        attn_qk(pn0, pn1, lds + qoff + c * 128, lds + A_KOFF + i * KSTR + hh * 16, negm);
#pragma nounroll
        for (int kt = 0; kt < nkt; ++kt) {
            const int cur = kt & 1;
            int qo = qoff + c * 128; asm volatile("" : "+v"(qo));
            const LAS unsigned char* qrow = lds + qo;
            if (kt + 2 < nkt) kreg = *(const v4u*)(ksrc + (size_t)(kt + 2) * 64 * DIN);
            if (kt + 1 < nkt) {
#pragma unroll
                for (int j = 0; j < 2; ++j) vreg[j] = *(const v4u*)(vsrc[j] + (kt + 1) * 64); }
            f32x16 pc0 = pn0, pc1 = pn1;
            attn_qk(pn0, pn1, qrow, lds + A_KOFF + (cur ^ 1) * A_KBUF + i * KSTR + hh * 16, negm);
            bf16x8 pf[4];
            attn_exp(pc0, pc1, M2, lsum, pf);
#pragma unroll
            for (int g = 0; g < 8; ++g) { __builtin_amdgcn_sched_group_barrier(0x008, 1, 0); __builtin_amdgcn_sched_group_barrier(0x002, 14, 0); }
            __builtin_amdgcn_sched_barrier(0);
            attn_pv(o, lds + A_VOFF + cur * A_VBUF + i * VSTR + hh * 8, pf);
            if (kt + 2 < nkt) *(LAS v4u*)(lds + kdst + cur * A_KBUF) = kreg;
            if (kt + 1 < nkt) {
#pragma unroll
                for (int j = 0; j < 2; ++j) { *(LAS v2u*)(lds + vdst[j] + (cur ^ 1) * A_VBUF) = (v2u){vreg[j].x, vreg[j].y}; *(LAS v2u*)(lds + vdst[j] + (cur ^ 1) * A_VBUF + 8) = (v2u){vreg[j].z, vreg[j].w}; } }
            LDS_BARRIER();
        }
        const float l = lsum + __shfl_xor(lsum, 32);
        if (c == 0) {
            const float i0 = 1.f / l;
#pragma unroll
            for (int db = 0; db < 4; ++db) {
                __builtin_amdgcn_sched_barrier(0);
                v4u w0, w1;
                w0.x = pk2(o[db][0] * i0, o[db][1] * i0); w0.y = pk2(o[db][2] * i0, o[db][3] * i0); w0.z = pk2(o[db][4] * i0, o[db][5] * i0); w0.w = pk2(o[db][6] * i0, o[db][7] * i0);
                w1.x = pk2(o[db][8] * i0, o[db][9] * i0); w1.y = pk2(o[db][10] * i0, o[db][11] * i0); w1.z = pk2(o[db][12] * i0, o[db][13] * i0); w1.w = pk2(o[db][14] * i0, o[db][15] * i0);
                stash[db * 2] = w0; stash[db * 2 + 1] = w1; }
        } else {
            int tid2 = tid_in; asm volatile("" : "+v"(tid2));
            const int i_e = tid2 & 31, hh_e = (tid2 >> 5) & 1, wave_e = __builtin_amdgcn_readfirstlane(tid2 >> 6);
            const float i1 = lam / l;
            float ss = 0.f;
#pragma unroll
            for (int db = 0; db < 4; ++db) {
                __builtin_amdgcn_sched_barrier(0);
                const v4u w0 = stash[db * 2], w1 = stash[db * 2 + 1];
                const unsigned ww[8] = {w0.x, w0.y, w0.z, w0.w, w1.x, w1.y, w1.z, w1.w};
#pragma unroll
                for (int r = 0; r < 16; r += 2) { const unsigned w = ww[r >> 1];
                    const float v0 = bflo(w) - o[db][r] * i1, v1 = bfhi(w) - o[db][r + 1] * i1; o[db][r] = v0; o[db][r + 1] = v1; ss = __builtin_fmaf(v0, v0, ss); ss = __builtin_fmaf(v1, v1, ss); } }
            __builtin_amdgcn_sched_barrier(0);
            ss += __shfl_xor(ss, 32);
            const float rs = rsqrtf(ss * (1.f / 128) + 1e-6f) * 0.8f;
            const size_t mq = (size_t)(m0 + qblk * 256 + wave_e * 32 + i_e);
#pragma unroll
            for (int db = 0; db < 4; ++db)
#pragma unroll
                for (int g = 0; g < 4; ++g) { const int d0 = 32 * db + 8 * g + 4 * hh_e;
                    __builtin_amdgcn_sched_barrier(0);
                    const v2u gw2 = *(const v2u*)(PROJ + mq * DIN + C_GD + hd * 128 + d0); const f32x4 sg4 = *(const f32x4*)(a.in[17] + d0);
                    const float g0 = bflo(gw2.x), g1 = bfhi(gw2.x), g2 = bflo(gw2.y), g3 = bfhi(gw2.y);
                    const float y0 = o[db][4 * g + 0] * rs * sg4.x * g0 * sigmoid_f(g0), y1 = o[db][4 * g + 1] * rs * sg4.y * g1 * sigmoid_f(g1),
                                y2 = o[db][4 * g + 2] * rs * sg4.z * g2 * sigmoid_f(g2), y3 = o[db][4 * g + 3] * rs * sg4.w * g3 * sigmoid_f(g3);
                    v2u w; w.x = pk2(y0, y1); w.y = pk2(y2, y3); *(v2u*)(CONCAT + mq * DM + 1024 + hd * 128 + d0) = w; }
        }
    }
}

__device__ __forceinline__ void rwkv_post(const Args& a, int wave, int lane) {
    const bf16* PROJ = (const bf16*)(a.ws + WS_PROJ); bf16* CONCAT = (bf16*)(a.ws + WS_CONCAT);
    const bf16* OF = (const bf16*)((unsigned char*)a.out + DO_OF); const bf16* OB = (const bf16*)((unsigned char*)a.out + DO_OB);
    const int gw = blockIdx.x * NWAVES + wave, NGW = gridDim.x * NWAVES;
    const int hg = gw & 3, col = (hg * 4 + (lane >> 4)) * 64 + (lane & 15) * 4;
    const f32x4 mu_r = *(const f32x4*)(a.in[4] + col), mu_k = *(const f32x4*)(a.in[4] + 1024 + col), mu_v = *(const f32x4*)(a.in[4] + 2048 + col);
    const f32x4 rk4 = *(const f32x4*)(a.in[11] + col), gg4 = *(const f32x4*)(a.in[12] + col), gb4 = *(const f32x4*)(a.in[13] + col);
    for (int m = gw >> 2; m < MTOK; m += NGW >> 2) {
        const int tpos = m < 8192 ? m : ((m - 8192) & 2047), T = m < 8192 ? 8192 : 2048;
        const float fp = tpos > 0 ? 0.5f : 0.f, fn = tpos < T - 1 ? 0.5f : 0.f;
        const int dp = tpos > 0 ? -DIN : 0, dn = tpos < T - 1 ? DIN : 0;
        const f32x4 of = unpk4(*(const v2u*)(OF + (size_t)m * 1024 + col)) + unpk4(*(const v2u*)(OB + (size_t)m * 1024 + col));
        const bf16* row = PROJ + (size_t)m * DIN + col;
        const f32x4 r0 = unpk4(*(const v2u*)row), rp = unpk4(*(const v2u*)(row + dp)), rn = unpk4(*(const v2u*)(row + dn));
        const f32x4 k0 = unpk4(*(const v2u*)(row + C_K)), kp = unpk4(*(const v2u*)(row + C_K + dp)), kn = unpk4(*(const v2u*)(row + C_K + dn));
        const f32x4 v0 = unpk4(*(const v2u*)(row + C_V)), vp = unpk4(*(const v2u*)(row + C_V + dp)), vn = unpk4(*(const v2u*)(row + C_V + dn));
        const f32x4 g = unpk4(*(const v2u*)(row + C_GR));
        const float mean = dpp_sum_row<16>(sum4(of)) * (1.f / 64);
        const f32x4 dv = of - mean;
        const float var = dpp_sum_row<16>(sum4(dv * dv)) * (1.f / 64);
        const f32x4 on = dv * rsqrtf(var + 64e-5f) * gg4 + gb4;
        const f32x4 rs = r0 + mu_r * (fp * rp + fn * rn - r0), ks = k0 + mu_k * (fp * kp + fn * kn - k0), vs = v0 + mu_v * (fp * vp + fn * vn - v0);
        const float bsum = dpp_sum_row<16>(sum4(rs * ks * rk4));
        f32x4 y = on + bsum * vs;
#pragma unroll
        for (int j = 0; j < 4; ++j) y[j] = y[j] * g[j] * fast_sigmoid(g[j]);
        v2u w; w.x = pk2(y.x, y.y); w.y = pk2(y.z, y.w);
        *(v2u*)(CONCAT + (size_t)m * DM + col) = w;
    }
}

constexpr int LDS_ARGS = LDS_BYTES - 512, LDS_XB = LDS_BYTES - 48;
constexpr int CW_BAR = 4096;
__device__ __forceinline__ const void* lds_arg_ptr(LAS unsigned char* lds, int k) {
    const v2u w = *(const LAS v2u*)(lds + LDS_ARGS + 8 * k);
    const unsigned lo = __builtin_amdgcn_readfirstlane(w.x), hi = __builtin_amdgcn_readfirstlane(w.y);
    return (const void*)(__attribute__((address_space(1))) const void*)(((unsigned long long)hi << 32) | lo);
}
#define LOAD_ARGS(la) Args la; do { _Pragma("unroll") for (int k_ = 0; k_ < 19; ++k_) la.in[k_] = (const float*)lds_arg_ptr(lds, k_); \
    la.out = (float*)lds_arg_ptr(lds, 19); la.ws = (unsigned char*)lds_arg_ptr(lds, 20); la.ph_lo = 0; la.ph_hi = 0; } while (0)

#define XB_TMO      128
#define XB_XCNT(j)  (256  + 64 * (j))
#define XB_XSUB(j)  (1280 + 64 * (j))
#define XB_XGEN(j)  (2304 + 64 * (j))
#define XB_TOP      3328
#define XB_TOPGEN   3392
#define XCD_BAR_WORDS 3456
#define XB_SPIN_CAP (1u << 18)

__device__ __forceinline__ unsigned xb_ld(unsigned* p)              { return __hip_atomic_load(p, __ATOMIC_RELAXED, __HIP_MEMORY_SCOPE_AGENT); }
__device__ __forceinline__ unsigned xb_add(unsigned* p, unsigned v) { return __hip_atomic_fetch_add(p, v, __ATOMIC_RELAXED, __HIP_MEMORY_SCOPE_AGENT); }
__device__ __forceinline__ unsigned xb_xcc_id() { return (unsigned)__builtin_amdgcn_s_getreg((3 << 11) | 20) & 0xFu; }
#define XB_SPIN(cond, bar) do { unsigned _sp = 0; while (cond) { __builtin_amdgcn_s_sleep(1); \
    if ((++_sp & 255u) == 0u) { if (xb_ld(&(bar)[XB_TMO])) break; if (_sp > XB_SPIN_CAP) { atomicAdd(&(bar)[XB_TMO], 1u); break; } } } } while (0)

struct XcdBarrier {
    unsigned* bar; unsigned x;
    volatile LAS unsigned* st;
};

__device__ __forceinline__ XcdBarrier xcd_barrier_post(unsigned* bar, volatile LAS unsigned* st) {
    XcdBarrier b; b.bar = bar; b.x = xb_xcc_id(); b.st = st;
    if (threadIdx.x == 0) (void)xb_add(&bar[XB_XCNT(b.x)], 1u);
    return b;
}
__device__ __forceinline__ void xcd_barrier_complete(unsigned* bar, unsigned x, unsigned& nloc, unsigned& nx) {
    const unsigned G = gridDim.x * gridDim.y * gridDim.z;
    unsigned sum, cnt, mine, sp = 0u;
    for (;;) {
        sum = 0u; cnt = 0u; mine = 0u;
#pragma unroll
        for (unsigned j = 0; j < 16; ++j) { const unsigned c = xb_ld(&bar[XB_XCNT(j)]); sum += c; cnt += (c > 0u) ? 1u : 0u; mine = (j == x) ? c : mine; }
        if (sum == G) break;
        __builtin_amdgcn_s_sleep(1);
        if ((++sp & 255u) == 0u) { if (xb_ld(&bar[XB_TMO])) break; if (sp > XB_SPIN_CAP) { atomicAdd(&bar[XB_TMO], 1u); break; } }
    }
    nloc = mine > 0u ? mine : 1u; nx = cnt > 0u ? cnt : 1u;
}

__device__ __forceinline__ void xcd_barrier(const XcdBarrier& b) {
    asm volatile("s_waitcnt vmcnt(0)" ::: "memory");
    __syncthreads();
    if (threadIdx.x == 0) {
        unsigned* bar = b.bar;
        __builtin_amdgcn_s_waitcnt(0);
        unsigned nloc = b.st[0], nx = b.st[1];
        if (nloc == 0u) { xcd_barrier_complete(bar, b.x, nloc, nx); b.st[0] = nloc; b.st[1] = nx; }
        const unsigned old = xb_add(&bar[XB_XSUB(b.x)], 1u);
        const unsigned gen = old / nloc;
        if (old + 1u == (gen + 1u) * nloc) {
            __builtin_amdgcn_fence(__ATOMIC_RELEASE, "agent");
            asm volatile("s_waitcnt vmcnt(0)" ::: "memory");
            const unsigned og = xb_add(&bar[XB_TOP], 1u);
            const unsigned tg = og / nx;
            if (og + 1u == (tg + 1u) * nx) xb_add(&bar[XB_TOPGEN], 1u);
            else XB_SPIN(xb_ld(&bar[XB_TOPGEN]) == tg, bar);
            __builtin_amdgcn_fence(__ATOMIC_ACQUIRE, "agent");
            xb_add(&bar[XB_XGEN(b.x)], 1u);
            asm volatile("s_waitcnt vmcnt(0)" ::: "memory");
        } else {
            XB_SPIN(xb_ld(&bar[XB_XGEN(b.x)]) == gen, bar);
            __builtin_amdgcn_fence(__ATOMIC_ACQUIRE, "agent");
            asm volatile("s_waitcnt vmcnt(0)" ::: "memory");
        }
    }
    __syncthreads();
}

__global__ void __launch_bounds__(NTHREADS, 2) hymba_fwd(Args a) {
    extern __shared__ __attribute__((aligned(16))) unsigned char lds_raw[];
    LAS unsigned char* lds = (LAS unsigned char*)lds_raw;
    const int tid = threadIdx.x, lane = tid & 63, wave = __builtin_amdgcn_readfirstlane(tid >> 6);
    const int lo = a.ph_lo, hi = a.ph_hi;
    if (tid < 21) { const unsigned long long v = tid < 19 ? (unsigned long long)a.in[tid < 19 ? tid : 0] : (tid == 19 ? (unsigned long long)a.out : (unsigned long long)a.ws); *(LAS unsigned long long*)(lds + LDS_ARGS + 8 * tid) = v; }
    if (tid < 2) *(LAS unsigned*)(lds + LDS_XB + 4 * tid) = 0u;
    __syncthreads();
    const XcdBarrier xbar = xcd_barrier_post((unsigned*)(a.ws + WS_CTL) + CW_BAR, (volatile LAS unsigned*)(lds + LDS_XB));
#define IN(k) (lo <= (k) && (k) < hi)
#define SEAM(k) do { if (IN(k) && IN((k) + 1)) { if ((k) == 0) cg::this_grid().sync(); else xcd_barrier(xbar); } } while (0)
        if (IN(0)) { p0_prologue(a, lds, tid, wave, lane); }
    SEAM(0);
    if (IN(1)) {
        pg8::Gemm g{(const pg8::bf16_t*)a.out, (const pg8::bf16_t*)(a.ws + WS_WIN), MTOK, DINP, DM}; pg8::StaticOrder S; S.init(MTOK, DINP, (int)gridDim.x, (int)blockIdx.x);
        pg8::EpiBf16 E{(pg8::bf16_t*)(a.ws + WS_PROJ), DIN, DIN};
        pg8::gemm_phase<pg8::EpiBf16, pg8::StaticOrder, true, true>(lds, g, S, E);
    }
    SEAM(1);
    if (IN(2)) { LOAD_ARGS(la); attn_prep(la, lds, wave, lane); }
    SEAM(2);
constexpr int UNITS_PER_PART = 8 + 32 + 32 + 64;
#define RUN_QUEUE(CBASE) do { \
        LAS unsigned* qslot = (LAS unsigned*)(lds + LDS_BYTES - 16); \
        const int p0_ = (int)(__builtin_amdgcn_s_getreg((3 << 11) | 20) & 7u); \
        for (int pi = 0; pi < 8; ++pi) { \
            const int p = (p0_ + pi) & 7; \
            unsigned* ctr = (unsigned*)(la.ws + WS_CTL) + 64 * ((CBASE) + p); \
            for (;;) { \
                if (tid == 0) *qslot = atomicAdd(ctr, 1u); \
                __syncthreads(); \
                const int li = (int)*qslot; \
                __syncthreads(); \
                if (li >= UNITS_PER_PART) break; \
                if (li < 8) { const int u = p * 8 + li; if ((u >> 1) & 1) scan_unit<1, 4>(la, lds, 0, u >> 2, u & 1, tid); else scan_unit<0, 4>(la, lds, 0, u >> 2, u & 1, tid); } \
                else if (li < 40) { attn_unit(la, lds, 0, p, li - 8, tid, M2u, lamu); } \
                else if (li < 72) { const int v = p * 32 + (li - 40), r = v & 31; if (r & 1) scan_unit<1, 8>(la, lds, 1 + (v >> 5), r >> 1, 0, tid); else scan_unit<0, 8>(la, lds, 1 + (v >> 5), r >> 1, 0, tid); } \
                else { const int j = li - 72; attn_unit(la, lds, 1 + (j >> 3), p, j & 7, tid, M2u, lamu); } \
            } } } while (0)
    if (IN(3)) {
        LOAD_ARGS(la);
        const float M2u = __builtin_bit_cast(float, __builtin_amdgcn_readfirstlane(__builtin_bit_cast(int, 11.6f * wave_max(fabsf(la.in[14][lane])) * wave_max(fabsf(la.in[15][lane])))));
        const float lamu = __builtin_bit_cast(float, __builtin_amdgcn_readfirstlane(__builtin_bit_cast(int, __expf(wave_sum(la.in[16][lane] * la.in[16][64 + lane])) - __expf(wave_sum(la.in[16][128 + lane] * la.in[16][192 + lane])) + 0.2f)));
        RUN_QUEUE(1);
    }
    SEAM(3);
    if (IN(4)) { LOAD_ARGS(la); rwkv_post(la, wave, lane); }
    SEAM(4);
    if (IN(5)) {
        LOAD_ARGS(la);
        pg8::Gemm g{(const pg8::bf16_t*)(la.ws + WS_CONCAT), (const pg8::bf16_t*)(la.ws + WS_WOUT), MTOK, DM, DM}; pg8::StaticOrder S; S.init(MTOK, DM, (int)gridDim.x, (int)blockIdx.x);
        pg8::EpiResF32 E{la.in[0], la.in[1], la.out};
        pg8::gemm_phase<pg8::EpiResF32, pg8::StaticOrder, true, true>(lds, g, S, E);
    }
#undef IN
#undef SEAM
}

extern "C" void kernel_launch(void* const* d_in, const int* in_sizes, int n_in, void* d_out, int out_size, void* d_ws, size_t ws_size, hipStream_t stream) {
    static int grid = 0;
    if (grid == 0) {
        if (n_in != 19 || out_size != MTOK * DM || ws_size < WS_TOTAL) { fprintf(stderr, "kernel_launch: unexpected shapes: n_in %d out %d ws %zu\n", n_in, out_size, ws_size); grid = -1; return; }
        int dev = 0, cus = 0, per_cu = 0;
        (void)hipGetDevice(&dev); (void)hipDeviceGetAttribute(&cus, hipDeviceAttributeMultiprocessorCount, dev);
        (void)hipFuncSetAttribute((const void*)hymba_fwd, hipFuncAttributeMaxDynamicSharedMemorySize, LDS_BYTES);
        (void)hipOccupancyMaxActiveBlocksPerMultiprocessor(&per_cu, (const void*)hymba_fwd, NTHREADS, LDS_BYTES);
        if (per_cu < 1) per_cu = 1;
        (void)hipGetLastError();
        grid = cus * per_cu;
        if (grid <= 0 || grid > 256) grid = 256;
    }
    if (grid < 0) return;
    (void)hipMemsetAsync((char*)d_ws + WS_CTL, 0, 65536, stream);
    Args a{};
    for (int i = 0; i < 19; ++i) a.in[i] = (const float*)d_in[i];
    a.out = (float*)d_out; a.ws = (unsigned char*)d_ws;
#if MK_N_LAUNCHES == 1
    a.ph_lo = 0; a.ph_hi = 6;
    void* args[] = {&a};
    hipError_t e = hipLaunchCooperativeKernel((const void*)hymba_fwd, dim3(grid), dim3(NTHREADS), args, LDS_BYTES, stream);
    if (e != hipSuccess) fprintf(stderr, "cooperative launch failed: %s (grid %d)\n", hipGetErrorString(e), grid);
#else
    for (int p = 0; p < 6; ++p) { a.ph_lo = p; a.ph_hi = p + 1; hipLaunchKernelGGL(hymba_fwd, dim3(grid), dim3(NTHREADS), LDS_BYTES, stream, a); }
#endif
}
```

```cpp
#include <hip/hip_runtime.h>
#include <hip/hip_cooperative_groups.h>
#include <cstdio>
#include <cstdint>
namespace cg = cooperative_groups;
#define MK_N_LAUNCHES 1
namespace pg8 {
#define PG8_LAS __attribute__((address_space(3)))
typedef unsigned short bf16_t;
typedef short bf16x8 __attribute__((ext_vector_type(8)));
typedef float f32x4 __attribute__((ext_vector_type(4)));
typedef unsigned u32x4 __attribute__((ext_vector_type(4)));
constexpr int BM = 256, BK = 64, HALF = 128, HTB = HALF * BK * 2  , STAGE_BYTES = 8 * HTB, NXCD = 8, WGM = 8;

__host__ __device__ __forceinline__ int lds_byte(int r, int c) { const int st = (r >> 4) * 2 + (c >> 5), rr = r & 15, cc = c & 31, ob = rr * 64 + cc * 2; return st * 1024 + (ob ^ (((ob >> 9) & 1) << 5)); }
__host__ __device__ __forceinline__ void stage_rc(int b, int& R, int& C) { const int st = b / 1024, sb = b % 1024, swz = sb ^ (((sb >> 9) & 1) << 5); R = (st >> 1) * 16 + swz / 64; C = (st & 1) * 32 + (swz % 64) / 2; }
__host__ __device__ __forceinline__ int perm32(int rho) { const int n = rho >> 4, i = rho & 15; return 8 * (i >> 2) + 4 * n + (i & 3); }

struct Unit { int pm, pn; };
struct Gemm { const bf16_t* A; const bf16_t* Bt; int M, N, K; };

struct StaticOrder {
    int nM, nN, nwg, G, c;
    __host__ __device__ void init(int M, int N, int G_, int c_) { nM = M / BM; nN = N / BM; nwg = nM * nN; G = G_; c = c_; }
    __host__ __device__ bool next(int i, Unit& u) const {
        const long L = (long)i * G + c; if (L >= nwg) return false;
        int wgid = (int)L; { const int q = nwg / NXCD, r = nwg % NXCD, xcd = wgid % NXCD, off = wgid / NXCD; wgid = (xcd < r ? xcd * (q + 1) : r * (q + 1) + (xcd - r) * q) + off; }
        const int nig = WGM * nN, gid = wgid / nig, fm = gid * WGM, gsz = (nM - fm) < WGM ? (nM - fm) : WGM;
        u.pm = fm + ((wgid % nig) % gsz); u.pn = (wgid % nig) / gsz; return true;
    }
    __device__ __forceinline__ void a_ready(const Unit&) const {}
    __device__ __forceinline__ void done(const Unit&) const {}
};


typedef float f32x2 __attribute__((ext_vector_type(2)));
typedef __bf16 bf16x2_t __attribute__((ext_vector_type(2)));
__device__ __forceinline__ unsigned cvt_pk_bf16(float lo, float hi) { f32x2 v = {lo, hi}; bf16x2_t b = __builtin_convertvector(v, bf16x2_t); return __builtin_bit_cast(unsigned, b); }

struct EpiBf16 {
    static constexpr bool PERM = true, AFTER_DRAIN = false;
    bf16_t* O; int ldc; int nvalid;
    __device__ __forceinline__ void operator()(const f32x4 (&acc)[2][2][4][2], const Unit& u, int wr, int wc, int fr, int fq) const {
        const int row0 = u.pm * BM + wr * 64 + fr; const int col0 = u.pn * BM + wc * 32 + 8 * fq;
#pragma unroll
        for (int ai = 0; ai < 2; ++ai)
#pragma unroll
            for (int m = 0; m < 4; ++m) { bf16_t* rowp = O + (size_t)(row0 + ai * HALF + m * 16) * ldc + col0;
#pragma unroll
                for (int bj = 0; bj < 2; ++bj) { if (col0 + bj * HALF < nvalid) { const f32x4 v0 = acc[ai][bj][m][0], v1 = acc[ai][bj][m][1];
                    u32x4 w; w.x = cvt_pk_bf16(v0[0], v0[1]); w.y = cvt_pk_bf16(v0[2], v0[3]); w.z = cvt_pk_bf16(v1[0], v1[1]); w.w = cvt_pk_bf16(v1[2], v1[3]);
                    __builtin_nontemporal_store(w, (u32x4*)(rowp + bj * HALF)); } } }
    }
};
struct EpiResF32 {
    static constexpr bool PERM = false, AFTER_DRAIN = false;
    const float* xp; const float* xs; float* out;
    __device__ __forceinline__ void operator()(const f32x4 (&acc)[2][2][4][2], const Unit& u, int wr, int wc, int fr, int fq) const {
        const int row0 = u.pm * BM + wr * 64 + fr; const int col0 = u.pn * BM + wc * 32 + 4 * fq;
        const float* xb = (u.pm * BM < 8192) ? xp : (xs - (size_t)8192 * 2048);
#pragma unroll
        for (int ai = 0; ai < 2; ++ai)
#pragma unroll
            for (int m = 0; m < 4; ++m) { const size_t off = (size_t)(row0 + ai * HALF + m * 16) * 2048 + col0;
#pragma unroll
                for (int bj = 0; bj < 2; ++bj)
#pragma unroll
                    for (int n = 0; n < 2; ++n) { const f32x4 xv = *(const f32x4*)(xb + off + bj * HALF + n * 16); *(f32x4*)(out + off + bj * HALF + n * 16) = xv + acc[ai][bj][m][n]; } }
    }
};
template <class Epi, class Sched, bool ALIGN_EPI = false, bool SP2 = false>
__device__ __forceinline__ void gemm_phase(PG8_LAS unsigned char* lds, const Gemm g, const Sched& S, const Epi& E) {
    const int tid = threadIdx.x, wid = __builtin_amdgcn_readfirstlane(tid >> 6), lane = tid & 63, wr = wid >> 2, wc = wid & 3, fr = lane & 15, fq = lane >> 4;
    const int K = g.K, nt = K / BK;
    unsigned voffA[2], voffB[2];
#pragma unroll
    for (int i = 0; i < 2; ++i) { int R, C; stage_rc(tid * 16 + i * 8192, R, C); const int Rb = Epi::PERM ? ((R & ~31) + perm32(R & 31)) : R;
        voffA[i] = (unsigned)(R * K + C) * 2u; voffB[i] = (unsigned)(Rb * K + C) * 2u; }
    const size_t kstep = (size_t)(BK * 2);
    const size_t hstep = (size_t)HALF * K * 2;
    const size_t tstep = 2 * hstep;
    const unsigned ldsw = (unsigned)wid * 1024u;
    const int aoff = lds_byte(wr * 64 + fr, fq * 8), boff = lds_byte(wc * 32 + fr, fq * 8);
#define PG8_SA(b, h) (((b) * 2 + (h)) * HTB)
#define PG8_SB(b, h) ((4 + (b) * 2 + (h)) * HTB)
#define PG8_STAGE(bufoff, gbase, voff) do { _Pragma("unroll") for (int _i = 0; _i < 2; ++_i) \
        __builtin_amdgcn_global_load_lds((const unsigned*)((const char*)(gbase) + (voff)[_i]), (PG8_LAS unsigned*)(lds + (bufoff) + ldsw + _i * 8192), 16, 0, 0); } while (0)
#define PG8_LDA(dst, b, h) do { _Pragma("unroll") for (int m = 0; m < 4; ++m) _Pragma("unroll") for (int k = 0; k < 2; ++k) dst[m][k] = *(const PG8_LAS bf16x8*)(lds + PG8_SA(b, h) + aoff + m * 2048 + k * 1024); } while (0)
#define PG8_LDB(dst, b, h) do { _Pragma("unroll") for (int n = 0; n < 2; ++n) _Pragma("unroll") for (int k = 0; k < 2; ++k) dst[n][k] = *(const PG8_LAS bf16x8*)(lds + PG8_SB(b, h) + boff + n * 2048 + k * 1024); } while (0)
#define PG8_MMA(ai, bj, At, Bt) do { __builtin_amdgcn_s_setprio(1); _Pragma("unroll") for (int m = 0; m < 4; ++m) _Pragma("unroll") for (int n = 0; n < 2; ++n) _Pragma("unroll") for (int k = 0; k < 2; ++k) \
        acc[ai][bj][m][n] = __builtin_amdgcn_mfma_f32_16x16x32_bf16(Bt[n][k], At[m][k], acc[ai][bj][m][n], 0, 0, 0); __builtin_amdgcn_s_setprio(0); } while (0)
#define PG8_WAIT_V(n) asm volatile("s_waitcnt vmcnt(" #n ")" ::: "memory")
#define PG8_WAIT_L(n) asm volatile("s_waitcnt lgkmcnt(" #n ")" ::: "memory")
#define PG8_BAR __builtin_amdgcn_s_barrier()
#define PG8_SCHED __builtin_amdgcn_sched_barrier(0)
    Unit cur, nxt; int ui = 0;
    if (!S.next(0, cur)) return;
    f32x4 acc[2][2][4][2];
#pragma unroll
    for (int a = 0; a < 2; ++a)
#pragma unroll
        for (int b = 0; b < 2; ++b)
#pragma unroll
            for (int m = 0; m < 4; ++m)
#pragma unroll
                for (int n = 0; n < 2; ++n) acc[a][b][m][n] = (f32x4){0.f, 0.f, 0.f, 0.f};
    bf16x8 At[4][2], B0[2][2], B1[2][2];
    const char* cA = (const char*)g.A + (size_t)cur.pm * tstep; const char* cB = (const char*)g.Bt + (size_t)cur.pn * tstep;
    S.a_ready(cur);
    if constexpr (SP2) {
        PG8_STAGE(PG8_SB(0, 0), cB, voffB); PG8_STAGE(PG8_SB(0, 1), cB + hstep, voffB); PG8_STAGE(PG8_SA(0, 0), cA, voffA); PG8_STAGE(PG8_SA(0, 1), cA + hstep, voffA);
        if (wr == 1) PG8_BAR;
        PG8_WAIT_V(2); PG8_BAR;
        PG8_STAGE(PG8_SB(1, 0), cB + kstep, voffB); PG8_STAGE(PG8_SA(1, 0), cA + kstep, voffA); PG8_STAGE(PG8_SB(1, 1), cB + hstep + kstep, voffB);
        PG8_WAIT_V(6); PG8_BAR;
    } else {
        PG8_STAGE(PG8_SB(0, 0), cB, voffB); PG8_STAGE(PG8_SA(0, 0), cA, voffA); PG8_STAGE(PG8_SB(0, 1), cB + hstep, voffB); PG8_STAGE(PG8_SA(0, 1), cA + hstep, voffA);
        if (wr == 1) PG8_BAR;
        PG8_WAIT_V(4); PG8_BAR;
        PG8_STAGE(PG8_SB(1, 0), cB + kstep, voffB); PG8_STAGE(PG8_SA(1, 0), cA + kstep, voffA); PG8_STAGE(PG8_SB(1, 1), cB + hstep + kstep, voffB);
        PG8_WAIT_V(6); PG8_BAR;
    }
    for (;;) {
        const bool has_next = S.next(ui + 1, nxt);
        const char* nA = has_next ? (const char*)g.A + (size_t)nxt.pm * tstep : cA; const char* nB = has_next ? (const char*)g.Bt + (size_t)nxt.pn * tstep : cB;
        for (int t = 0; t < nt; t += 2) {
            const bool last = (t == nt - 2);
            const char* a1 = cA + (size_t)(t + 1) * kstep;
            const char* a2 = last ? nA : cA + (size_t)(t + 2) * kstep; const char* b2 = last ? nB : cB + (size_t)(t + 2) * kstep;
            const char* a3 = a2 + kstep; const char* b3 = b2 + kstep;
            if (last && has_next) S.a_ready(nxt);
            if constexpr (SP2) {
            PG8_LDB(B0, 0, 0); PG8_LDB(B1, 0, 1); PG8_SCHED; PG8_LDA(At, 0, 0); PG8_STAGE(PG8_SA(1, 1), a1 + hstep, voffA);
            PG8_WAIT_V(8); PG8_WAIT_L(0); PG8_BAR; PG8_MMA(0, 0, At, B0); PG8_MMA(0, 1, At, B1); PG8_BAR; PG8_SCHED;
            PG8_LDA(At, 0, 1); PG8_STAGE(PG8_SB(0, 0), b2, voffB); PG8_STAGE(PG8_SB(0, 1), b2 + hstep, voffB); PG8_STAGE(PG8_SA(0, 0), a2, voffA);
            PG8_WAIT_V(8); PG8_WAIT_L(0); PG8_BAR; PG8_MMA(1, 0, At, B0); PG8_MMA(1, 1, At, B1); PG8_BAR; PG8_SCHED;
            PG8_LDB(B0, 1, 0); PG8_LDB(B1, 1, 1); PG8_SCHED; PG8_LDA(At, 1, 0); PG8_STAGE(PG8_SA(0, 1), a2 + hstep, voffA);
            PG8_WAIT_V(8); PG8_WAIT_L(0); PG8_BAR; PG8_MMA(0, 0, At, B0); PG8_MMA(0, 1, At, B1); PG8_BAR; PG8_SCHED;
            PG8_LDA(At, 1, 1); PG8_STAGE(PG8_SB(1, 0), b3, voffB); PG8_STAGE(PG8_SB(1, 1), b3 + hstep, voffB); PG8_STAGE(PG8_SA(1, 0), a3, voffA);
            PG8_WAIT_V(8); PG8_WAIT_L(0); PG8_BAR; PG8_MMA(1, 0, At, B0); PG8_MMA(1, 1, At, B1); PG8_BAR; PG8_SCHED;
            } else {
            PG8_LDB(B0, 0, 0); PG8_SCHED; PG8_LDA(At, 0, 0); PG8_STAGE(PG8_SA(1, 1), a1 + hstep, voffA);
            PG8_WAIT_L(8); PG8_BAR; PG8_WAIT_L(0); PG8_MMA(0, 0, At, B0); PG8_BAR; PG8_SCHED;
            PG8_LDB(B1, 0, 1); PG8_STAGE(PG8_SB(0, 0), b2, voffB);
            PG8_BAR; PG8_WAIT_L(0); PG8_MMA(0, 1, At, B1); PG8_BAR;
            PG8_LDA(At, 0, 1); PG8_STAGE(PG8_SA(0, 0), a2, voffA);
            PG8_BAR; PG8_WAIT_L(0); PG8_MMA(1, 0, At, B0); PG8_BAR; PG8_SCHED;
            PG8_STAGE(PG8_SB(0, 1), b2 + hstep, voffB);
            PG8_WAIT_V(6); PG8_BAR; PG8_MMA(1, 1, At, B1); PG8_BAR;
            PG8_LDB(B0, 1, 0); PG8_SCHED; PG8_LDA(At, 1, 0); PG8_STAGE(PG8_SA(0, 1), a2 + hstep, voffA);
            PG8_WAIT_L(8); PG8_BAR; PG8_WAIT_L(0); PG8_MMA(0, 0, At, B0); PG8_BAR; PG8_SCHED;
            PG8_LDB(B1, 1, 1); PG8_STAGE(PG8_SB(1, 0), b3, voffB);
            PG8_BAR; PG8_WAIT_L(0); PG8_MMA(0, 1, At, B1); PG8_BAR;
            PG8_LDA(At, 1, 1); PG8_STAGE(PG8_SA(1, 0), a3, voffA);
            PG8_BAR; PG8_WAIT_L(0); PG8_MMA(1, 0, At, B0); PG8_BAR; PG8_SCHED;
            PG8_STAGE(PG8_SB(1, 1), b3 + hstep, voffB);
            PG8_WAIT_V(6); PG8_BAR; PG8_MMA(1, 1, At, B1); PG8_BAR;
            }
        }
        if constexpr (ALIGN_EPI) { if (wr == 0) PG8_BAR; }
        if constexpr (!Epi::AFTER_DRAIN) { E(acc, cur, wr, wc, fr, fq); S.done(cur); }
        if (!has_next) break;
#pragma unroll
        for (int a = 0; a < 2; ++a)
#pragma unroll
            for (int b = 0; b < 2; ++b)
#pragma unroll
                for (int m = 0; m < 4; ++m)
#pragma unroll
                    for (int n = 0; n < 2; ++n) acc[a][b][m][n] = (f32x4){0.f, 0.f, 0.f, 0.f};
        cur = nxt; cA = nA; cB = nB; ++ui;
        if constexpr (ALIGN_EPI) { if (wr == 1) PG8_BAR; }
    }
    PG8_WAIT_V(0);
    if constexpr (!ALIGN_EPI) { if (wr == 0) PG8_BAR; }
    PG8_BAR;
    if constexpr (Epi::AFTER_DRAIN) { E.fused(acc, cur, wr, wc, fr, fq, lds, wid, lane); S.done(cur); }
#undef PG8_SA
#undef PG8_SB
#undef PG8_STAGE
#undef PG8_LDA
#undef PG8_LDB
#undef PG8_MMA
#undef PG8_WAIT_V
#undef PG8_WAIT_L
#undef PG8_BAR
#undef PG8_SCHED
}
}

#ifndef MK_N_LAUNCHES
#define MK_N_LAUNCHES 1
#endif
constexpr int NWAVES = 8, NTHREADS = 512;
constexpr int DM = 2048, MTOK = 24576, DIN = 8320, DINP = 8448;
constexpr int C_K = 1024, C_V = 2048, C_WD = 3072, C_AD = 3136, C_GR = 3200, C_QD = 4224, C_KD = 5248, C_VD = 6272, C_GD = 7296;
constexpr size_t MiB = 1u << 20;
constexpr size_t WS_CTL = 0, WS_WOUT = 1 * MiB, WS_PROJ = 10 * MiB, WS_CONCAT = 400 * MiB, WS_WIN = 400 * MiB, WS_END = 496 * MiB, WS_TOTAL = 512 * MiB;
constexpr size_t DO_OF = 48 * MiB, DO_OB = 96 * MiB, DO_VT = 144 * MiB;
constexpr int LDS_BYTES = 147456;
constexpr float QSCALE = 0.18033688011112042f;

#define LAS __attribute__((address_space(3)))
typedef unsigned short bf16;
typedef unsigned v4u __attribute__((ext_vector_type(4)));
typedef unsigned v2u __attribute__((ext_vector_type(2)));
typedef float f32x4 __attribute__((ext_vector_type(4)));
typedef float f32x16 __attribute__((ext_vector_type(16)));
typedef short bf16x8 __attribute__((ext_vector_type(8)));
typedef short s16x4 __attribute__((ext_vector_type(4)));

__device__ __forceinline__ float bf2f(bf16 v) { return __uint_as_float(((unsigned)v) << 16); }
__device__ __forceinline__ float bflo(unsigned w) { return __uint_as_float(w << 16); }
__device__ __forceinline__ float bfhi(unsigned w) { return __uint_as_float(w & 0xffff0000u); }
__device__ __forceinline__ unsigned pk2(float lo, float hi) { return pg8::cvt_pk_bf16(lo, hi); }
__device__ __forceinline__ bf16 f2bf(float f) { return (bf16)(pk2(f, 0.f) & 0xffffu); }
__device__ __forceinline__ float wave_sum(float v) {
#pragma unroll
    for (int o = 1; o < 64; o <<= 1) v += __shfl_xor(v, o);
    return v;
}
__device__ __forceinline__ float wave_max(float v) {
#pragma unroll
    for (int o = 1; o < 64; o <<= 1) v = fmaxf(v, __shfl_xor(v, o));
    return v;
}
__device__ __forceinline__ float sigmoid_f(float x) { return 1.0f / (1.0f + __expf(-x)); }

__device__ __forceinline__ f32x4 unpk4(v2u w) { return (f32x4){bflo(w.x), bfhi(w.x), bflo(w.y), bfhi(w.y)}; }
__device__ __forceinline__ float sum4(f32x4 v) { return (v.x + v.y) + (v.z + v.w); }
struct Args { const float* in[19]; float* out; unsigned char* ws; int ph_lo, ph_hi; };

__device__ __forceinline__ void p0_transpose_item(const float* W, int K, int N, bf16* WT, LAS float* scr, int item, int lane) {
    const int nblk = N / 32, kb = item / nblk, nb = item % nblk, k0 = 64 * kb, n0 = 32 * nb;
#pragma unroll 8
    for (int i = 0; i < 32; ++i) { const int kk = 2 * i + (lane >> 5); scr[kk * 33 + (lane & 31)] = W[(size_t)(k0 + kk) * N + n0 + (lane & 31)]; }
    asm volatile("s_waitcnt lgkmcnt(0)" ::: "memory");
    const int c = lane & 7;
#pragma unroll
    for (int j = 0; j < 4; ++j) { const int n = (lane >> 3) + 8 * j; const LAS float* s = scr + (8 * c) * 33 + n;
        v4u o; o.x = pk2(s[0 * 33], s[1 * 33]); o.y = pk2(s[2 * 33], s[3 * 33]); o.z = pk2(s[4 * 33], s[5 * 33]); o.w = pk2(s[6 * 33], s[7 * 33]);
        *(v4u*)(WT + (size_t)(n0 + n) * K + k0 + 8 * c) = o; }
    asm volatile("s_waitcnt lgkmcnt(0)" ::: "memory");
}
__device__ __forceinline__ void rms_row_to_bf16(const float* xrow, const float* gain, bf16* orow, int lane) {
    const f32x4* xr = (const f32x4*)xrow + lane; const f32x4* gr = (const f32x4*)gain + lane;
    f32x4 v[8]; float s = 0.f;
#pragma unroll
    for (int j = 0; j < 8; ++j) { v[j] = xr[64 * j]; s += (v[j].x * v[j].x + v[j].y * v[j].y) + (v[j].z * v[j].z + v[j].w * v[j].w); }
    const float rstd = rsqrtf(wave_sum(s) * (1.f / DM) + 1e-6f);
    unsigned long long* o8 = (unsigned long long*)orow + lane;
#pragma unroll
    for (int j = 0; j < 8; ++j) { const f32x4 g = gr[64 * j];
        o8[64 * j] = (unsigned long long)pk2(v[j].x * rstd * g.x, v[j].y * rstd * g.y) | ((unsigned long long)pk2(v[j].z * rstd * g.z, v[j].w * rstd * g.w) << 32); }
}
__device__ __forceinline__ void p0_prologue(const Args& a, LAS unsigned char* lds, int tid, int wave, int lane) {
    LAS float* scr = (LAS float*)(lds + wave * 16384);
    const int gw = blockIdx.x * NWAVES + wave, NGW = gridDim.x * NWAVES;
    bf16* Win_t = (bf16*)(a.ws + WS_WIN); bf16* Wout_t = (bf16*)(a.ws + WS_WOUT); bf16* XN = (bf16*)a.out;
    constexpr int I_IN = (DM / 64) * (DIN / 32), I_OUT = (DM / 64) * (DM / 32);
    for (int it = gw; it < I_IN + I_OUT; it += NGW) {
        if (it < I_IN) p0_transpose_item(a.in[3], DM, DIN, Win_t, scr, it, lane);
        else p0_transpose_item(a.in[18], DM, DM, Wout_t, scr, it - I_IN, lane);
    }
    { v4u* z = (v4u*)(Win_t + (size_t)DIN * DM); const v4u zero = {0u, 0u, 0u, 0u};
      for (int i = blockIdx.x * NTHREADS + tid; i < (DINP - DIN) * DM * 2 / 16; i += gridDim.x * NTHREADS) z[i] = zero; }
    for (int m = gw; m < MTOK; m += NGW) {
        const float* xrow = m < 8192 ? a.in[0] + (size_t)m * DM : a.in[1] + (size_t)(m - 8192) * DM;
        rms_row_to_bf16(xrow, a.in[2], XN + (size_t)m * DM, lane);
    }
}

__device__ __forceinline__ float dpp_sum16(float v) {
    v += __builtin_bit_cast(float, __builtin_amdgcn_update_dpp(0, __builtin_bit_cast(int, v), 0xB1, 0xf, 0xf, true));
    v += __builtin_bit_cast(float, __builtin_amdgcn_update_dpp(0, __builtin_bit_cast(int, v), 0x4E, 0xf, 0xf, true));
    v += __builtin_bit_cast(float, __builtin_amdgcn_update_dpp(0, __builtin_bit_cast(int, v), 0x141, 0xf, 0xf, true));
    v += __builtin_bit_cast(float, __builtin_amdgcn_update_dpp(0, __builtin_bit_cast(int, v), 0x140, 0xf, 0xf, true));
    return v;
}
__device__ __forceinline__ float dpp_xor2(float v) { return __builtin_bit_cast(float, __builtin_amdgcn_update_dpp(0, __builtin_bit_cast(int, v), 0x4E, 0xf, 0xf, true)); }
__device__ __forceinline__ void attn_prep(const Args& a, LAS unsigned char* lds, int wave, int lane) {
    bf16* PROJ = (bf16*)(a.ws + WS_PROJ); bf16* VT = (bf16*)((unsigned char*)a.out + DO_VT);
    const int vec = lane >> 4, c16 = lane & 15;
    const f32x4 gain4 = *(const f32x4*)((vec < 2 ? a.in[14] : a.in[15]) + c16 * 4);
    const float oscale = vec < 2 ? QSCALE : 1.f;
    const int vcol = (vec < 2 ? C_QD : C_KD) + (vec & 1) * 64 + c16 * 4;
    f32x4 invf4;
#pragma unroll
    for (int j = 0; j < 4; ++j) invf4[j] = exp2f(-(float)((c16 & 1) * 4 + j) * 2.3664460711655218f) * 0.15915494309189535f;
    const float sgn = (c16 & 2) ? 1.f : -1.f;
    LAS unsigned char* tile = lds + wave * 16640;
    const int gw = blockIdx.x * NWAVES + wave, NGW = gridDim.x * NWAVES;
    unsigned* const pctr = (unsigned*)(a.ws + WS_CTL) + 64 * 24;
    for (;;) {
        int item = 0; if (lane == 0) item = (int)atomicAdd(pctr, 1u);
        item = __builtin_amdgcn_readfirstlane(item);
        if (item >= 8 * 384) break;
        const int hd = item / 384, gblk = item % 384, mb = gblk * 64;
        const int tpos0 = mb < 8192 ? mb : ((mb - 8192) & 2047);
#pragma unroll 2
        for (int tok = 0; tok < 64; ++tok) {
            bf16* p = PROJ + (size_t)(mb + tok) * DIN + hd * 128 + vcol;
            f32x4 x = unpk4(*(const v2u*)p);
            const float ss = dpp_sum16((x.x * x.x + x.y * x.y) + (x.z * x.z + x.w * x.w));
            x = x * (rsqrtf(ss * (1.f / 64) + 1e-6f) * oscale) * gain4;
            const float tf = (float)(tpos0 + tok);
            f32x4 xr;
#pragma unroll
            for (int j = 0; j < 4; ++j) { float rev = tf * invf4[j]; rev -= floorf(rev);
                const float cs = __builtin_amdgcn_cosf(rev), sn = __builtin_amdgcn_sinf(rev) * sgn;
                xr[j] = x[j] * cs + dpp_xor2(x[j]) * sn; }
            if (c16 < 4) x = xr;
            v2u w; w.x = pk2(x.x, x.y); w.y = pk2(x.z, x.w);
            *(v2u*)p = w;
        }
#pragma unroll 4
        for (int it = 0; it < 16; ++it) { const int id = it * 64 + lane, r = id >> 4, ch = id & 15;
            const v4u val = *(const v4u*)(PROJ + (size_t)(mb + r) * DIN + C_VD + hd * 128 + ch * 8);
            LAS unsigned* dst = (LAS unsigned*)(tile + r * 260 + ch * 16); dst[0] = val.x; dst[1] = val.y; dst[2] = val.z; dst[3] = val.w; }
        asm volatile("s_waitcnt lgkmcnt(0)" ::: "memory");
#pragma unroll 8
        for (int d = 0; d < 128; ++d) { const bf16 v = *(const LAS bf16*)(tile + lane * 260 + d * 2); VT[(size_t)(hd * 128 + d) * MTOK + mb + lane] = v; }
        asm volatile("s_waitcnt lgkmcnt(0)" ::: "memory");
    }
}

constexpr int TC = 32, ZSTR = 784;
constexpr int LB_KK = 0, LB_WW = LB_KK + TC * 256, LB_BB = LB_WW + TC * 256, LB_KD = LB_BB + TC * 256, LB_RR = LB_KD + TC * 256, LB_VV = LB_RR + TC * 256, LB_OUT = LB_VV + TC * 256,
              LB_ZS = LB_OUT + TC * 256  , LB_RAW = LB_ZS + TC * ZSTR, LB_MU = LB_RAW + (TC + 2) * 640, LB_END = LB_MU + 1280;
static_assert(LB_END <= LDS_BYTES - 64, "scan LDS");
typedef float f32x2v __attribute__((ext_vector_type(2)));
template <int LPR> __device__ __forceinline__ float dpp_sum_row(float v) {
    v += __builtin_bit_cast(float, __builtin_amdgcn_update_dpp(0, __builtin_bit_cast(int, v), 0xB1, 0xf, 0xf, true));
    v += __builtin_bit_cast(float, __builtin_amdgcn_update_dpp(0, __builtin_bit_cast(int, v), 0x4E, 0xf, 0xf, true));
    v += __builtin_bit_cast(float, __builtin_amdgcn_update_dpp(0, __builtin_bit_cast(int, v), 0x141, 0xf, 0xf, true));
    if (LPR == 16) v += __builtin_bit_cast(float, __builtin_amdgcn_update_dpp(0, __builtin_bit_cast(int, v), 0x140, 0xf, 0xf, true));
    return v;
}
__device__ __forceinline__ float fast_sigmoid(float x) { return __builtin_amdgcn_rcpf(1.0f + __expf(-x)); }
#define LDS_BARRIER() asm volatile("s_waitcnt lgkmcnt(0)\n\ts_barrier" ::: "memory")
template <int DIR, int RPW>
__device__ __forceinline__ void scan_unit(const Args& a, LAS unsigned char* lds, int seq, int h, int half, int tid_in) {
    constexpr int LPR = 64 / RPW, KS = RPW, NP = KS / 2, OSTR = 8 * RPW;
    int tid = tid_in; asm volatile("" : "+v"(tid));
    const int lane = tid & 63, wave = __builtin_amdgcn_readfirstlane(tid >> 6);
    const bf16* PROJ = (const bf16*)(a.ws + WS_PROJ);
    bf16* OD = (bf16*)((unsigned char*)a.out + (DIR ? DO_OB : DO_OF));
    const int m0 = seq == 0 ? 0 : 8192 + (seq - 1) * 2048, T = seq == 0 ? 8192 : 2048, nch = T / TC;
    const int rbase = RPW == 4 ? half * 32 : 0;
    const int sb_t = tid >> 4, c16 = tid & 15;
    if (tid < 320) { const int g = tid >> 6, c = tid & 63; const int gc = g < 3 ? g * 1024 + h * 64 + c : (g == 3 ? C_WD + c : C_AD + c); ((LAS float*)(lds + LB_MU))[tid] = a.in[4][gc]; }
    const f32x4 kk4c = *(const f32x4*)(a.in[9] + h * 64 + c16 * 4);
    const int mat = wave >> 2, nt4 = wave & 3, quad = lane >> 4, l15 = lane & 15, ncol = h * 64 + nt4 * 16 + l15;
    const float c0v = (mat == 0 ? a.in[5] : a.in[7])[DIR * 1024 + ncol], kav = a.in[10][ncol];
    bf16x8 bfr[2];
    { const float* UP = (mat == 0 ? a.in[6] : a.in[8]) + (size_t)DIR * 64 * 1024 + ncol;
#pragma unroll
      for (int ks = 0; ks < 2; ++ks) { float x[8];
#pragma unroll
          for (int j = 0; j < 8; ++j) x[j] = UP[(size_t)(ks * 32 + quad * 8 + j) * 1024];
          v4u p; p.x = pk2(x[0], x[1]); p.y = pk2(x[2], x[3]); p.z = pk2(x[4], x[5]); p.w = pk2(x[6], x[7]); bfr[ks] = __builtin_bit_cast(bf16x8, p); } }
    int crr[3], ccol[3], coff[3]; bool cval[3];
#pragma unroll
    for (int i = 0; i < 3; ++i) { const int ch = tid + 512 * i; cval[i] = ch < (TC + 2) * 40; const int rr = ch / 40, rem = ch % 40, g = rem >> 3, c8 = rem & 7;
        crr[i] = rr; ccol[i] = (g < 3 ? g * 1024 + h * 64 : (g == 3 ? C_WD : C_AD)) + c8 * 8; coff[i] = LB_RAW + rr * 640 + (g * 64 + c8 * 8) * 2; }
    f32x2v S[NP];
#pragma unroll
    for (int j = 0; j < NP; ++j) S[j] = (f32x2v){0.f, 0.f};
    const int rowl = lane / LPR, kq = lane % LPR, vrow = rbase + wave * RPW + rowl;
    const LAS unsigned char* opb = lds + kq * (KS * 4);
    const LAS unsigned char* vvb = lds + LB_VV + vrow * 4;
    LAS float* outp = (LAS float*)(lds + LB_OUT) + wave * RPW + rowl;
    v4u pre[3];
#define SCAN_LOAD(cc) do { const int t0_ = (DIR ? nch - 1 - (cc) : (cc)) * TC; _Pragma("unroll") for (int i = 0; i < 3; ++i) { const int t_ = t0_ - 1 + crr[i]; \
        const bool ok_ = cval[i] && t_ >= 0 && t_ < T; v4u z_ = {0u, 0u, 0u, 0u}; if (ok_) z_ = *(const v4u*)(PROJ + (size_t)(m0 + t_) * DIN + ccol[i]); pre[i] = z_; } } while (0)
    SCAN_LOAD(0);
#pragma unroll
    for (int i = 0; i < 3; ++i) if (cval[i]) *(LAS v4u*)(lds + coff[i]) = pre[i];
    LDS_BARRIER();
    if (nch > 1) SCAN_LOAD(1);
#pragma nounroll
    for (int c = 0; c < nch; ++c) {
        const int t0 = (DIR ? nch - 1 - c : c) * TC;
#pragma unroll
        for (int g = 0; g < 5; ++g) {
            const LAS unsigned char* rp = lds + LB_RAW + sb_t * 640 + (g * 64 + c16 * 4) * 2;
            const v2u wp = *(const LAS v2u*)rp, wz = *(const LAS v2u*)(rp + 640), wn = *(const LAS v2u*)(rp + 1280);
            const f32x4 mu4 = *(const LAS f32x4*)(lds + LB_MU + (g * 64 + c16 * 4) * 4);
            const f32x4 z = {bflo(wz.x), bfhi(wz.x), bflo(wz.y), bfhi(wz.y)}, zp = {bflo(wp.x), bfhi(wp.x), bflo(wp.y), bfhi(wp.y)}, zn = {bflo(wn.x), bfhi(wn.x), bflo(wn.y), bfhi(wn.y)};
            f32x4 zs = z + mu4 * (0.5f * (zp + zn) - z);
            if (g == 3) {
#pragma unroll
                for (int j = 0; j < 4; ++j) zs[j] = 1.f - 2.f * __builtin_amdgcn_rcpf(__expf(2.f * zs[j]) + 1.f); }
            *(LAS f32x4*)(lds + (g == 0 ? LB_RR + sb_t * 256 : g == 2 ? LB_VV + sb_t * 256 : LB_ZS + sb_t * ZSTR + (g == 1 ? 0 : g == 3 ? 256 : 512)) + c16 * 16) = zs;
            if (g == 1) { const f32x4 kr = zs * kk4c; const float ss = dpp_sum_row<16>((kr.x * kr.x + kr.y * kr.y) + (kr.z * kr.z + kr.w * kr.w));
                *(LAS f32x4*)(lds + LB_KK + sb_t * 256 + c16 * 16) = kr * rsqrtf(fmaxf(ss, 1e-12f)); }
        }
        LDS_BARRIER();
#pragma unroll
        for (int mt = 0; mt < 2; ++mt) { f32x4 acc = {0.f, 0.f, 0.f, 0.f};
#pragma unroll
            for (int ks = 0; ks < 2; ++ks) { const LAS unsigned char* ap = lds + LB_ZS + (mt * 16 + l15) * ZSTR + (64 + mat * 64 + ks * 32 + quad * 8) * 4;
                const f32x4 x0 = *(const LAS f32x4*)ap, x1 = *(const LAS f32x4*)(ap + 16);
                v4u p; p.x = pk2(x0.x, x0.y); p.y = pk2(x0.z, x0.w); p.z = pk2(x1.x, x1.y); p.w = pk2(x1.z, x1.w);
                acc = __builtin_amdgcn_mfma_f32_16x16x32_bf16(__builtin_bit_cast(bf16x8, p), bfr[ks], acc, 0, 0, 0); }
#pragma unroll
            for (int j = 0; j < 4; ++j) { const int t = mt * 16 + quad * 4 + j, n = nt4 * 16 + l15; const float sg = fast_sigmoid(acc[j] + c0v);
                if (mat == 0) *(LAS float*)(lds + LB_WW + t * 256 + n * 4) = __expf(-0.606531f * sg);
                else { const float kv = *(const LAS float*)(lds + LB_ZS + t * ZSTR + n * 4);
                    *(LAS float*)(lds + LB_KD + t * 256 + n * 4) = kv * (1.f + (sg - 1.f) * kav); *(LAS float*)(lds + LB_BB + t * 256 + n * 4) = sg * *(const LAS float*)(lds + LB_KK + t * 256 + n * 4); } } }
        LDS_BARRIER();
        {
#define SC_LD(tt, KK2, W2, B2, KD2, R2, VV) do { _Pragma("unroll") for (int q_ = 0; q_ < NP; ++q_) { KK2[q_] = *(const LAS f32x2v*)(gb + LB_KK + (tt) * 256 + q_ * 8); W2[q_] = *(const LAS f32x2v*)(gb + LB_WW + (tt) * 256 + q_ * 8); \
            B2[q_] = *(const LAS f32x2v*)(gb + LB_BB + (tt) * 256 + q_ * 8); KD2[q_] = *(const LAS f32x2v*)(gb + LB_KD + (tt) * 256 + q_ * 8); R2[q_] = *(const LAS f32x2v*)(gb + LB_RR + (tt) * 256 + q_ * 8); } VV = *(const LAS float*)(gv + (tt) * 256); } while (0)
            f32x2v kk2[NP], w2[NP], b2[NP], kd2[NP], r2[NP]; float vv;
            { const int tf = DIR ? TC - 1 : 0; const LAS unsigned char* gb = opb + tf * 256; const LAS unsigned char* gv = vvb + tf * 256; SC_LD(0, kk2, w2, b2, kd2, r2, vv); }
#pragma nounroll
            for (int so = 0; so < 4; ++so) {
                constexpr int bias = DIR ? 1 : 0;
                const int tbase = (DIR ? TC - 8 - 8 * so : 8 * so) - bias;
                const LAS unsigned char* gb = opb + tbase * 256; const LAS unsigned char* gv = vvb + tbase * 256;
                LAS float* go = outp + tbase * OSTR;
#pragma unroll
                for (int j = 0; j < 8; ++j) { const int tj = (DIR ? 7 - j : j) + bias, tn = DIR ? tj - 1 : tj + 1;
                    f32x2v nkk2[NP], nw2[NP], nb2[NP], nkd2[NP], nr2[NP]; float nvv = vv;
#pragma unroll
                    for (int q = 0; q < NP; ++q) { nkk2[q] = kk2[q]; nw2[q] = w2[q]; nb2[q] = b2[q]; nkd2[q] = kd2[q]; nr2[q] = r2[q]; }
                    if (j < 7 || so < 3) SC_LD(tn, nkk2, nw2, nb2, nkd2, nr2, nvv);
                    f32x2v acc = S[0] * kk2[0];
#pragma unroll
                    for (int q = 1; q < NP; ++q) acc = S[q] * kk2[q] + acc;
                    const float sa = -dpp_sum_row<LPR>(acc.x + acc.y);
                    const f32x2v sa2 = {sa, sa}, vv2 = {vv, vv};
#pragma unroll
                    for (int q = 0; q < NP; ++q) S[q] = S[q] * w2[q] + (vv2 * kd2[q] + sa2 * b2[q]);
                    f32x2v oc = S[0] * r2[0];
#pragma unroll
                    for (int q = 1; q < NP; ++q) oc = S[q] * r2[q] + oc;
                    go[tj * OSTR] = dpp_sum_row<LPR>(oc.x + oc.y);
                    vv = nvv;
#pragma unroll
                    for (int q = 0; q < NP; ++q) { kk2[q] = nkk2[q]; w2[q] = nw2[q]; b2[q] = nb2[q]; kd2[q] = nkd2[q]; r2[q] = nr2[q]; }
                }
            }
#undef SC_LD
        }
        if (c + 1 < nch) {
#pragma unroll
            for (int i = 0; i < 3; ++i) if (cval[i]) *(LAS v4u*)(lds + coff[i]) = pre[i]; }
        LDS_BARRIER();
        if (c + 2 < nch) SCAN_LOAD(c + 2);
        if (tid < TC * RPW) { const int t = tid / RPW, q8 = tid % RPW; const LAS float* o = (const LAS float*)(lds + LB_OUT) + t * OSTR + q8 * 8;
            v4u w; w.x = pk2(o[0], o[1]); w.y = pk2(o[2], o[3]); w.z = pk2(o[4], o[5]); w.w = pk2(o[6], o[7]);
            *(v4u*)(OD + (size_t)(m0 + t0 + t) * 1024 + h * 64 + rbase + q8 * 8) = w; }
    }
#undef SCAN_LOAD
}

constexpr int QSTR = 272, KSTR = 144, VSTR = 136;
constexpr int A_QOFF = 0, A_KOFF = 256 * QSTR, A_KBUF = 64 * KSTR, A_VOFF = A_KOFF + 2 * A_KBUF, A_VBUF = 128 * VSTR, A_END = A_VOFF + 2 * A_VBUF;
static_assert(A_END <= LDS_BYTES - 64, "attention LDS");
#define MFMA32(a_, b_, c_) __builtin_amdgcn_mfma_f32_32x32x16_bf16((a_), (b_), (c_), 0, 0, 0)
__device__ __forceinline__ bf16x8 pack8(const f32x16& p, int b) {
    v4u w; w.x = pk2(p[b], p[b + 1]); w.y = pk2(p[b + 2], p[b + 3]); w.z = pk2(p[b + 4], p[b + 5]); w.w = pk2(p[b + 6], p[b + 7]); return __builtin_bit_cast(bf16x8, w);
}
__device__ __forceinline__ void attn_qk(f32x16& p0, f32x16& p1, const LAS unsigned char* qrow, const LAS unsigned char* Kb, const f32x16& negm) {
#pragma unroll
    for (int s = 0; s < 4; ++s) {
        const bf16x8 qf = *(const LAS bf16x8*)(qrow + s * 32);
        const bf16x8 a0 = *(const LAS bf16x8*)(Kb + s * 32), a1 = *(const LAS bf16x8*)(Kb + 32 * KSTR + s * 32);
        if (s == 0) { p0 = MFMA32(a0, qf, negm); p1 = MFMA32(a1, qf, negm); }
        else { p0 = MFMA32(a0, qf, p0); p1 = MFMA32(a1, qf, p1); }
    }
}
__device__ __forceinline__ void attn_exp(f32x16& p0, f32x16& p1, float M2, float& lsum, bf16x8 (&pf)[4]) {
    float ls = 0.f;
#pragma unroll
    for (int r = 0; r < 16; ++r) { p0[r] = __builtin_amdgcn_exp2f(p0[r]); p1[r] = __builtin_amdgcn_exp2f(p1[r]); ls += p0[r] + p1[r]; }
    lsum += ls;
    pf[0] = pack8(p0, 0); pf[1] = pack8(p0, 8); pf[2] = pack8(p1, 0); pf[3] = pack8(p1, 8);
}
__device__ __forceinline__ void attn_pv(f32x16 (&o)[4], const LAS unsigned char* Vb, const bf16x8 (&pf)[4]) {
    s16x4 lo[4], hi[4];
#pragma unroll
    for (int s2 = 0; s2 < 4; ++s2) { lo[s2] = *(const LAS s16x4*)(Vb + s2 * 32); hi[s2] = *(const LAS s16x4*)(Vb + s2 * 32 + 16); }
#pragma unroll
    for (int db = 0; db < 4; ++db) {
        s16x4 nlo[4], nhi[4];
#pragma unroll
        for (int s2 = 0; s2 < 4; ++s2) { nlo[s2] = lo[s2]; nhi[s2] = hi[s2]; }
        if (db < 3) {
#pragma unroll
            for (int s2 = 0; s2 < 4; ++s2) { nlo[s2] = *(const LAS s16x4*)(Vb + (db + 1) * 32 * VSTR + s2 * 32); nhi[s2] = *(const LAS s16x4*)(Vb + (db + 1) * 32 * VSTR + s2 * 32 + 16); } }
        __builtin_amdgcn_sched_barrier(0);
#pragma unroll
        for (int s2 = 0; s2 < 4; ++s2) o[db] = MFMA32(__builtin_shufflevector(lo[s2], hi[s2], 0, 1, 2, 3, 4, 5, 6, 7), pf[s2], o[db]);
        __builtin_amdgcn_sched_barrier(0);
#pragma unroll
        for (int s2 = 0; s2 < 4; ++s2) { lo[s2] = nlo[s2]; hi[s2] = nhi[s2]; }
    }
}
__device__ __forceinline__ void attn_unit(const Args& a, LAS unsigned char* lds, int seq, int hd, int qblk, int tid_in, float M2, float lam) {
    int tid = tid_in; asm volatile("" : "+v"(tid));
    const int lane = tid & 63, wave = __builtin_amdgcn_readfirstlane(tid >> 6);
    const bf16* PROJ = (const bf16*)(a.ws + WS_PROJ); const bf16* VT = (const bf16*)((const unsigned char*)a.out + DO_VT); bf16* CONCAT = (bf16*)(a.ws + WS_CONCAT);
    const int m0 = seq == 0 ? 0 : 8192 + (seq - 1) * 2048, T = seq == 0 ? 8192 : 2048, nkt = T / 64;
    const int i = lane & 31, hh = lane >> 5;
    const int mq0 = m0 + qblk * 256 + wave * 32;
#pragma unroll
    for (int it = 0; it < 8; ++it) { const int id = it * 64 + lane, r = id >> 4, ch = id & 15;
        const v4u v = *(const v4u*)(PROJ + (size_t)(mq0 + r) * DIN + C_QD + hd * 128 + ch * 8);
        *(LAS v4u*)(lds + A_QOFF + (wave * 32 + r) * QSTR + ch * 16) = v; }
    const bf16* vsrc[2]; int vdst[2];
#pragma unroll
    for (int j = 0; j < 2; ++j) { const int id = tid + 512 * j, d = id >> 3, ch = id & 7; vsrc[j] = VT + (size_t)(hd * 128 + d) * MTOK + m0 + ch * 8; vdst[j] = A_VOFF + d * VSTR + ch * 16; }
    const int kdst = A_KOFF + (tid >> 3) * KSTR + (tid & 7) * 16;
    const int qoff = A_QOFF + (wave * 32 + i) * QSTR + hh * 16;
    f32x16 negm;
#pragma unroll
    for (int r = 0; r < 16; ++r) negm[r] = -M2;
    asm volatile("" : "+v"(negm));
    v4u* const stash = (v4u*)(a.ws + WS_END) + ((size_t)blockIdx.x * NTHREADS + tid_in) * 8;
#pragma nounroll
    for (int c = 0; c < 2; ++c) {
        const bf16* ksrc = PROJ + (size_t)(m0 + (tid >> 3)) * DIN + C_KD + hd * 128 + c * 64 + (tid & 7) * 8;
        v4u kreg, vreg[2];
        kreg = *(const v4u*)ksrc;
#pragma unroll
        for (int j = 0; j < 2; ++j) vreg[j] = *(const v4u*)vsrc[j];
        *(LAS v4u*)(lds + kdst) = kreg;
#pragma unroll
        for (int j = 0; j < 2; ++j) { *(LAS v2u*)(lds + vdst[j]) = (v2u){vreg[j].x, vreg[j].y}; *(LAS v2u*)(lds + vdst[j] + 8) = (v2u){vreg[j].z, vreg[j].w}; }
        kreg = *(const v4u*)(ksrc + (size_t)64 * DIN);
        *(LAS v4u*)(lds + kdst + A_KBUF) = kreg;
        LDS_BARRIER();
        f32x16 o[4];
#pragma unroll
        for (int db = 0; db < 4; ++db)
#pragma unroll
            for (int r = 0; r < 16; ++r) o[db][r] = 0.f;
        float lsum = 0.f;
        f32x16 pn0, pn1;
        attn_qk(pn0, pn1, lds + qoff + c * 128, lds + A_KOFF + i * KSTR + hh * 16, negm);
#pragma nounroll
        for (int kt = 0; kt < nkt; ++kt) {
            const int cur = kt & 1;
            int qo = qoff + c * 128; asm volatile("" : "+v"(qo));
            const LAS unsigned char* qrow = lds + qo;
            if (kt + 2 < nkt) kreg = *(const v4u*)(ksrc + (size_t)(kt + 2) * 64 * DIN);
            if (kt + 1 < nkt) {
#pragma unroll
                for (int j = 0; j < 2; ++j) vreg[j] = *(const v4u*)(vsrc[j] + (kt + 1) * 64); }
            f32x16 pc0 = pn0, pc1 = pn1;
            attn_qk(pn0, pn1, qrow, lds + A_KOFF + (cur ^ 1) * A_KBUF + i * KSTR + hh * 16, negm);
            bf16x8 pf[4];
            attn_exp(pc0, pc1, M2, lsum, pf);
#pragma unroll
            for (int g = 0; g < 8; ++g) { __builtin_amdgcn_sched_group_barrier(0x008, 1, 0); __builtin_amdgcn_sched_group_barrier(0x002, 14, 0); }
            __builtin_amdgcn_sched_barrier(0);
            attn_pv(o, lds + A_VOFF + cur * A_VBUF + i * VSTR + hh * 8, pf);
            if (kt + 2 < nkt) *(LAS v4u*)(lds + kdst + cur * A_KBUF) = kreg;
            if (kt + 1 < nkt) {
#pragma unroll
                for (int j = 0; j < 2; ++j) { *(LAS v2u*)(lds + vdst[j] + (cur ^ 1) * A_VBUF) = (v2u){vreg[j].x, vreg[j].y}; *(LAS v2u*)(lds + vdst[j] + (cur ^ 1) * A_VBUF + 8) = (v2u){vreg[j].z, vreg[j].w}; } }
            LDS_BARRIER();
        }
        const float l = lsum + __shfl_xor(lsum, 32);
        if (c == 0) {
            const float i0 = 1.f / l;
#pragma unroll
            for (int db = 0; db < 4; ++db) {
                __builtin_amdgcn_sched_barrier(0);
                v4u w0, w1;
                w0.x = pk2(o[db][0] * i0, o[db][1] * i0); w0.y = pk2(o[db][2] * i0, o[db][3] * i0); w0.z = pk2(o[db][4] * i0, o[db][5] * i0); w0.w = pk2(o[db][6] * i0, o[db][7] * i0);
                w1.x = pk2(o[db][8] * i0, o[db][9] * i0); w1.y = pk2(o[db][10] * i0, o[db][11] * i0); w1.z = pk2(o[db][12] * i0, o[db][13] * i0); w1.w = pk2(o[db][14] * i0, o[db][15] * i0);
                stash[db * 2] = w0; stash[db * 2 + 1] = w1; }
        } else {
            int tid2 = tid_in; asm volatile("" : "+v"(tid2));
            const int i_e = tid2 & 31, hh_e = (tid2 >> 5) & 1, wave_e = __builtin_amdgcn_readfirstlane(tid2 >> 6);
            const float i1 = lam / l;
            float ss = 0.f;
#pragma unroll
            for (int db = 0; db < 4; ++db) {
                __builtin_amdgcn_sched_barrier(0);
                const v4u w0 = stash[db * 2], w1 = stash[db * 2 + 1];
                const unsigned ww[8] = {w0.x, w0.y, w0.z, w0.w, w1.x, w1.y, w1.z, w1.w};
#pragma unroll
                for (int r = 0; r < 16; r += 2) { const unsigned w = ww[r >> 1];
                    const float v0 = bflo(w) - o[db][r] * i1, v1 = bfhi(w) - o[db][r + 1] * i1; o[db][r] = v0; o[db][r + 1] = v1; ss = __builtin_fmaf(v0, v0, ss); ss = __builtin_fmaf(v1, v1, ss); } }
            __builtin_amdgcn_sched_barrier(0);
            ss += __shfl_xor(ss, 32);
            const float rs = rsqrtf(ss * (1.f / 128) + 1e-6f) * 0.8f;
            const size_t mq = (size_t)(m0 + qblk * 256 + wave_e * 32 + i_e);
#pragma unroll
            for (int db = 0; db < 4; ++db)
#pragma unroll
                for (int g = 0; g < 4; ++g) { const int d0 = 32 * db + 8 * g + 4 * hh_e;
                    __builtin_amdgcn_sched_barrier(0);
                    const v2u gw2 = *(const v2u*)(PROJ + mq * DIN + C_GD + hd * 128 + d0); const f32x4 sg4 = *(const f32x4*)(a.in[17] + d0);
                    const float g0 = bflo(gw2.x), g1 = bfhi(gw2.x), g2 = bflo(gw2.y), g3 = bfhi(gw2.y);
                    const float y0 = o[db][4 * g + 0] * rs * sg4.x * g0 * sigmoid_f(g0), y1 = o[db][4 * g + 1] * rs * sg4.y * g1 * sigmoid_f(g1),
                                y2 = o[db][4 * g + 2] * rs * sg4.z * g2 * sigmoid_f(g2), y3 = o[db][4 * g + 3] * rs * sg4.w * g3 * sigmoid_f(g3);
                    v2u w; w.x = pk2(y0, y1); w.y = pk2(y2, y3); *(v2u*)(CONCAT + mq * DM + 1024 + hd * 128 + d0) = w; }
        }
    }
}

__device__ __forceinline__ void rwkv_post(const Args& a, int wave, int lane) {
    const bf16* PROJ = (const bf16*)(a.ws + WS_PROJ); bf16* CONCAT = (bf16*)(a.ws + WS_CONCAT);
    const bf16* OF = (const bf16*)((unsigned char*)a.out + DO_OF); const bf16* OB = (const bf16*)((unsigned char*)a.out + DO_OB);
    const int gw = blockIdx.x * NWAVES + wave, NGW = gridDim.x * NWAVES;
    const int hg = gw & 3, col = (hg * 4 + (lane >> 4)) * 64 + (lane & 15) * 4;
    const f32x4 mu_r = *(const f32x4*)(a.in[4] + col), mu_k = *(const f32x4*)(a.in[4] + 1024 + col), mu_v = *(const f32x4*)(a.in[4] + 2048 + col);
    const f32x4 rk4 = *(const f32x4*)(a.in[11] + col), gg4 = *(const f32x4*)(a.in[12] + col), gb4 = *(const f32x4*)(a.in[13] + col);
    for (int m = gw >> 2; m < MTOK; m += NGW >> 2) {
        const int tpos = m < 8192 ? m : ((m - 8192) & 2047), T = m < 8192 ? 8192 : 2048;
        const float fp = tpos > 0 ? 0.5f : 0.f, fn = tpos < T - 1 ? 0.5f : 0.f;
        const int dp = tpos > 0 ? -DIN : 0, dn = tpos < T - 1 ? DIN : 0;
        const f32x4 of = unpk4(*(const v2u*)(OF + (size_t)m * 1024 + col)) + unpk4(*(const v2u*)(OB + (size_t)m * 1024 + col));
        const bf16* row = PROJ + (size_t)m * DIN + col;
        const f32x4 r0 = unpk4(*(const v2u*)row), rp = unpk4(*(const v2u*)(row + dp)), rn = unpk4(*(const v2u*)(row + dn));
        const f32x4 k0 = unpk4(*(const v2u*)(row + C_K)), kp = unpk4(*(const v2u*)(row + C_K + dp)), kn = unpk4(*(const v2u*)(row + C_K + dn));
        const f32x4 v0 = unpk4(*(const v2u*)(row + C_V)), vp = unpk4(*(const v2u*)(row + C_V + dp)), vn = unpk4(*(const v2u*)(row + C_V + dn));
        const f32x4 g = unpk4(*(const v2u*)(row + C_GR));
        const float mean = dpp_sum_row<16>(sum4(of)) * (1.f / 64);
        const f32x4 dv = of - mean;
        const float var = dpp_sum_row<16>(sum4(dv * dv)) * (1.f / 64);
        const f32x4 on = dv * rsqrtf(var + 64e-5f) * gg4 + gb4;
        const f32x4 rs = r0 + mu_r * (fp * rp + fn * rn - r0), ks = k0 + mu_k * (fp * kp + fn * kn - k0), vs = v0 + mu_v * (fp * vp + fn * vn - v0);
        const float bsum = dpp_sum_row<16>(sum4(rs * ks * rk4));
        f32x4 y = on + bsum * vs;
#pragma unroll
        for (int j = 0; j < 4; ++j) y[j] = y[j] * g[j] * fast_sigmoid(g[j]);
        v2u w; w.x = pk2(y.x, y.y); w.y = pk2(y.z, y.w);
        *(v2u*)(CONCAT + (size_t)m * DM + col) = w;
    }
}

constexpr int LDS_ARGS = LDS_BYTES - 512, LDS_XB = LDS_BYTES - 48;
constexpr int CW_BAR = 4096;
__device__ __forceinline__ const void* lds_arg_ptr(LAS unsigned char* lds, int k) {
    const v2u w = *(const LAS v2u*)(lds + LDS_ARGS + 8 * k);
    const unsigned lo = __builtin_amdgcn_readfirstlane(w.x), hi = __builtin_amdgcn_readfirstlane(w.y);
    return (const void*)(__attribute__((address_space(1))) const void*)(((unsigned long long)hi << 32) | lo);
}
#define LOAD_ARGS(la) Args la; do { _Pragma("unroll") for (int k_ = 0; k_ < 19; ++k_) la.in[k_] = (const float*)lds_arg_ptr(lds, k_); \
    la.out = (float*)lds_arg_ptr(lds, 19); la.ws = (unsigned char*)lds_arg_ptr(lds, 20); la.ph_lo = 0; la.ph_hi = 0; } while (0)

#define XB_TMO      128
#define XB_XCNT(j)  (256  + 64 * (j))
#define XB_XSUB(j)  (1280 + 64 * (j))
#define XB_XGEN(j)  (2304 + 64 * (j))
#define XB_TOP      3328
#define XB_TOPGEN   3392
#define XCD_BAR_WORDS 3456
#define XB_SPIN_CAP (1u << 18)

__device__ __forceinline__ unsigned xb_ld(unsigned* p)              { return __hip_atomic_load(p, __ATOMIC_RELAXED, __HIP_MEMORY_SCOPE_AGENT); }
__device__ __forceinline__ unsigned xb_add(unsigned* p, unsigned v) { return __hip_atomic_fetch_add(p, v, __ATOMIC_RELAXED, __HIP_MEMORY_SCOPE_AGENT); }
__device__ __forceinline__ unsigned xb_xcc_id() { return (unsigned)__builtin_amdgcn_s_getreg((3 << 11) | 20) & 0xFu; }
#define XB_SPIN(cond, bar) do { unsigned _sp = 0; while (cond) { __builtin_amdgcn_s_sleep(1); \
    if ((++_sp & 255u) == 0u) { if (xb_ld(&(bar)[XB_TMO])) break; if (_sp > XB_SPIN_CAP) { atomicAdd(&(bar)[XB_TMO], 1u); break; } } } } while (0)

struct XcdBarrier {
    unsigned* bar; unsigned x;
    volatile LAS unsigned* st;
};

__device__ __forceinline__ XcdBarrier xcd_barrier_post(unsigned* bar, volatile LAS unsigned* st) {
    XcdBarrier b; b.bar = bar; b.x = xb_xcc_id(); b.st = st;
    if (threadIdx.x == 0) (void)xb_add(&bar[XB_XCNT(b.x)], 1u);
    return b;
}
__device__ __forceinline__ void xcd_barrier_complete(unsigned* bar, unsigned x, unsigned& nloc, unsigned& nx) {
    const unsigned G = gridDim.x * gridDim.y * gridDim.z;
    unsigned sum, cnt, mine, sp = 0u;
    for (;;) {
        sum = 0u; cnt = 0u; mine = 0u;
#pragma unroll
        for (unsigned j = 0; j < 16; ++j) { const unsigned c = xb_ld(&bar[XB_XCNT(j)]); sum += c; cnt += (c > 0u) ? 1u : 0u; mine = (j == x) ? c : mine; }
        if (sum == G) break;
        __builtin_amdgcn_s_sleep(1);
        if ((++sp & 255u) == 0u) { if (xb_ld(&bar[XB_TMO])) break; if (sp > XB_SPIN_CAP) { atomicAdd(&bar[XB_TMO], 1u); break; } }
    }
    nloc = mine > 0u ? mine : 1u; nx = cnt > 0u ? cnt : 1u;
}

__device__ __forceinline__ void xcd_barrier(const XcdBarrier& b) {
    asm volatile("s_waitcnt vmcnt(0)" ::: "memory");
    __syncthreads();
    if (threadIdx.x == 0) {
        unsigned* bar = b.bar;
        __builtin_amdgcn_s_waitcnt(0);
        unsigned nloc = b.st[0], nx = b.st[1];
        if (nloc == 0u) { xcd_barrier_complete(bar, b.x, nloc, nx); b.st[0] = nloc; b.st[1] = nx; }
        const unsigned old = xb_add(&bar[XB_XSUB(b.x)], 1u);
        const unsigned gen = old / nloc;
        if (old + 1u == (gen + 1u) * nloc) {
            __builtin_amdgcn_fence(__ATOMIC_RELEASE, "agent");
            asm volatile("s_waitcnt vmcnt(0)" ::: "memory");
            const unsigned og = xb_add(&bar[XB_TOP], 1u);
            const unsigned tg = og / nx;
            if (og + 1u == (tg + 1u) * nx) xb_add(&bar[XB_TOPGEN], 1u);
            else XB_SPIN(xb_ld(&bar[XB_TOPGEN]) == tg, bar);
            __builtin_amdgcn_fence(__ATOMIC_ACQUIRE, "agent");
            xb_add(&bar[XB_XGEN(b.x)], 1u);
            asm volatile("s_waitcnt vmcnt(0)" ::: "memory");
        } else {
            XB_SPIN(xb_ld(&bar[XB_XGEN(b.x)]) == gen, bar);
            __builtin_amdgcn_fence(__ATOMIC_ACQUIRE, "agent");
            asm volatile("s_waitcnt vmcnt(0)" ::: "memory");
        }
    }
    __syncthreads();
}

struct OneUnit {
    int pm, pn;
    __device__ __forceinline__ bool next(int i, pg8::Unit& u) const { if (i != 0) return false; u.pm = pm; u.pn = pn; return true; }
    __device__ __forceinline__ void a_ready(const pg8::Unit&) const {}
    __device__ __forceinline__ void done(const pg8::Unit&) const {}
};
__global__ void __launch_bounds__(NTHREADS, 2) hymba_fwd(Args a) {
    extern __shared__ __attribute__((aligned(16))) unsigned char lds_raw[];
    LAS unsigned char* lds = (LAS unsigned char*)lds_raw;
    const int tid = threadIdx.x, lane = tid & 63, wave = __builtin_amdgcn_readfirstlane(tid >> 6);
    const int lo = a.ph_lo, hi = a.ph_hi;
    if (tid < 21) { const unsigned long long v = tid < 19 ? (unsigned long long)a.in[tid < 19 ? tid : 0] : (tid == 19 ? (unsigned long long)a.out : (unsigned long long)a.ws); *(LAS unsigned long long*)(lds + LDS_ARGS + 8 * tid) = v; }
    if (tid < 2) *(LAS unsigned*)(lds + LDS_XB + 4 * tid) = 0u;
    __syncthreads();
    const XcdBarrier xbar = xcd_barrier_post((unsigned*)(a.ws + WS_CTL) + CW_BAR, (volatile LAS unsigned*)(lds + LDS_XB));
#define IN(k) (lo <= (k) && (k) < hi)
#define SEAM(k) do { if (IN(k) && IN((k) + 1)) { if ((k) == 0) cg::this_grid().sync(); else xcd_barrier(xbar); } } while (0)
        if (IN(0)) { p0_prologue(a, lds, tid, wave, lane); }
    SEAM(0);
    if (IN(1)) {
        pg8::Gemm g{(const pg8::bf16_t*)a.out, (const pg8::bf16_t*)(a.ws + WS_WIN), MTOK, DINP, DM}; pg8::StaticOrder S; S.init(MTOK, 8192, (int)gridDim.x, (int)blockIdx.x);
        pg8::EpiBf16 E{(pg8::bf16_t*)(a.ws + WS_PROJ), DIN, DIN};
        pg8::gemm_phase<pg8::EpiBf16, pg8::StaticOrder, true, true>(lds, g, S, E);
    }
    SEAM(1);
    if (IN(2)) { LOAD_ARGS(la);
        if (blockIdx.x < MTOK / 256) {
            pg8::Gemm g{(const pg8::bf16_t*)la.out, (const pg8::bf16_t*)(la.ws + WS_WIN), MTOK, DINP, DM}; const OneUnit S{(int)blockIdx.x, DINP / 256 - 1};
            pg8::EpiBf16 E{(pg8::bf16_t*)(la.ws + WS_PROJ), DIN, DIN};
            pg8::gemm_phase<pg8::EpiBf16, OneUnit, true, true>(lds, g, S, E);
        }
        attn_prep(la, lds, wave, lane); }
    SEAM(2);
constexpr int UNITS_PER_PART = 8 + 32 + 32 + 64;
#define RUN_QUEUE(CBASE) do { \
        LAS unsigned* qslot = (LAS unsigned*)(lds + LDS_BYTES - 16); \
        const int p0_ = (int)(__builtin_amdgcn_s_getreg((3 << 11) | 20) & 7u); \
        for (int pi = 0; pi < 8; ++pi) { \
            const int p = (p0_ + pi) & 7; \
            unsigned* ctr = (unsigned*)(la.ws + WS_CTL) + 64 * ((CBASE) + p); \
            for (;;) { \
                if (tid == 0) *qslot = atomicAdd(ctr, 1u); \
                __syncthreads(); \
                const int li = (int)*qslot; \
                __syncthreads(); \
                if (li >= UNITS_PER_PART) break; \
                if (li < 8) { const int u = p * 8 + li; if ((u >> 1) & 1) scan_unit<1, 4>(la, lds, 0, u >> 2, u & 1, tid); else scan_unit<0, 4>(la, lds, 0, u >> 2, u & 1, tid); } \
                else if (li < 40) { attn_unit(la, lds, 0, p, li - 8, tid, M2u, lamu); } \
                else if (li < 72) { const int v = p * 32 + (li - 40), r = v & 31; if (r & 1) scan_unit<1, 8>(la, lds, 1 + (v >> 5), r >> 1, 0, tid); else scan_unit<0, 8>(la, lds, 1 + (v >> 5), r >> 1, 0, tid); } \
                else { const int j = li - 72; attn_unit(la, lds, 1 + (j >> 3), p, j & 7, tid, M2u, lamu); } \
            } } } while (0)
    if (IN(3)) {
        LOAD_ARGS(la);
        const float M2u = __builtin_bit_cast(float, __builtin_amdgcn_readfirstlane(__builtin_bit_cast(int, 11.6f * wave_max(fabsf(la.in[14][lane])) * wave_max(fabsf(la.in[15][lane])))));
        const float lamu = __builtin_bit_cast(float, __builtin_amdgcn_readfirstlane(__builtin_bit_cast(int, __expf(wave_sum(la.in[16][lane] * la.in[16][64 + lane])) - __expf(wave_sum(la.in[16][128 + lane] * la.in[16][192 + lane])) + 0.2f)));
        RUN_QUEUE(1);
    }
    SEAM(3);
    if (IN(4)) { LOAD_ARGS(la); rwkv_post(la, wave, lane); }
    SEAM(4);
    if (IN(5)) {
        LOAD_ARGS(la);
        pg8::Gemm g{(const pg8::bf16_t*)(la.ws + WS_CONCAT), (const pg8::bf16_t*)(la.ws + WS_WOUT), MTOK, DM, DM}; pg8::StaticOrder S; S.init(MTOK, DM, (int)gridDim.x, (int)blockIdx.x);
        pg8::EpiResF32 E{la.in[0], la.in[1], la.out};
        pg8::gemm_phase<pg8::EpiResF32, pg8::StaticOrder, true, true>(lds, g, S, E);
    }
#undef IN
#undef SEAM
}

extern "C" void kernel_launch(void* const* d_in, const int* in_sizes, int n_in, void* d_out, int out_size, void* d_ws, size_t ws_size, hipStream_t stream) {
    static int grid = 0;
    if (grid == 0) {
        if (n_in != 19 || out_size != MTOK * DM || ws_size < WS_TOTAL) { fprintf(stderr, "kernel_launch: unexpected shapes: n_in %d out %d ws %zu\n", n_in, out_size, ws_size); grid = -1; return; }
        int dev = 0, cus = 0, per_cu = 0;
        (void)hipGetDevice(&dev); (void)hipDeviceGetAttribute(&cus, hipDeviceAttributeMultiprocessorCount, dev);
        (void)hipFuncSetAttribute((const void*)hymba_fwd, hipFuncAttributeMaxDynamicSharedMemorySize, LDS_BYTES);
        (void)hipOccupancyMaxActiveBlocksPerMultiprocessor(&per_cu, (const void*)hymba_fwd, NTHREADS, LDS_BYTES);
        if (per_cu < 1) per_cu = 1;
        (void)hipGetLastError();
        grid = cus * per_cu;
        if (grid <= 0 || grid > 256) grid = 256;
    }
    if (grid < 0) return;
    (void)hipMemsetAsync((char*)d_ws + WS_CTL, 0, 65536, stream);
    Args a{};
    for (int i = 0; i < 19; ++i) a.in[i] = (const float*)d_in[i];
    a.out = (float*)d_out; a.ws = (unsigned char*)d_ws;
#if MK_N_LAUNCHES == 1
    a.ph_lo = 0; a.ph_hi = 6;
    void* args[] = {&a};
    hipError_t e = hipLaunchCooperativeKernel((const void*)hymba_fwd, dim3(grid), dim3(NTHREADS), args, LDS_BYTES, stream);
    if (e != hipSuccess) fprintf(stderr, "cooperative launch failed: %s (grid %d)\n", hipGetErrorString(e), grid);
#else
    for (int p = 0; p < 6; ++p) { a.ph_lo = p; a.ph_hi = p + 1; hipLaunchKernelGGL(hymba_fwd, dim3(grid), dim3(NTHREADS), LDS_BYTES, stream, a); }
#endif
}
```
